# Optimizing an MI355X kernel written in HIP

```python
import math
import jax, jax.numpy as jnp
from jax import lax
import numpy as np

D_MODEL = 2048
BATCH = 4
SEQ = 2048
DEPTH = 1

ATTN_HEADS = 8
HEAD_DIM = 128
ATTN_WIDTH = ATTN_HEADS * HEAD_DIM
REC_WIDTH = D_MODEL - ATTN_WIDTH
MIX_WIDTH = ATTN_WIDTH + REC_WIDTH
REC_BLOCKS = 8
REC_BLOCK = REC_WIDTH // REC_BLOCKS
CONV_WIDTH = 4
LRU_C = 8.0
IN_COLS = 3 * ATTN_WIDTH + 2 * REC_WIDTH
DILATED_PATTERNS = ((128, 1), (512, 4), (2048, 16))
ROPE_THETA = 10000.0
NEG_INF = -1e30
PEER_HEADS = 8
PEER_NKEYS = 128
PEER_EXPERTS = PEER_NKEYS * PEER_NKEYS
PEER_QDIM = 256
PEER_HALF = PEER_QDIM // 2
PEER_TOPK = 16
PEER_CHUNK = 128
DN_ALPHA = (2.0 * DEPTH) ** 0.25
DN_BETA = (8.0 * DEPTH) ** -0.25
LN_EPS = 1e-5

kernel_name = 'hymba_rglru_dilated_attn_peer'


def layer_norm(x, g, b):
    xf = x.astype(jnp.float32)
    mu = jnp.mean(xf, -1, keepdims=True)
    var = jnp.mean(jnp.square(xf - mu), -1, keepdims=True)
    return ((xf - mu) * lax.rsqrt(var + LN_EPS) * g.astype(jnp.float32) + b.astype(jnp.float32)).astype(x.dtype)


def rms_norm(x, g):
    xf = x.astype(jnp.float32)
    return xf * lax.rsqrt(jnp.mean(jnp.square(xf), -1, keepdims=True) + LN_EPS) * g.astype(jnp.float32)


def rope(x, positions):
    half = HEAD_DIM // 2
    inv = ROPE_THETA ** (-jnp.arange(half, dtype=jnp.float32) / half)
    ang = positions.astype(jnp.float32)[..., None] * inv
    cos = jnp.cos(ang)[:, :, None, :]
    sin = jnp.sin(ang)[:, :, None, :]
    x1, x2 = x[..., :half], x[..., half:]
    return jnp.concatenate([x1 * cos - x2 * sin, x2 * cos + x1 * sin], -1)


def banded_causal_attn(q, k, v, band):
    *lead, L, hd = q.shape
    nb = -(-L // band)
    lp = nb * band
    nlead = len(lead)
    qb = jnp.pad(q, [(0, 0)] * nlead + [(0, lp - L), (0, 0)]).reshape(*lead, nb, band, hd)
    kvpad = [(0, 0)] * nlead + [(band, lp - L), (0, 0)]
    kb = jnp.pad(k, kvpad).reshape(*lead, nb + 1, band, hd)
    vb = jnp.pad(v, kvpad).reshape(*lead, nb + 1, band, hd)
    kw = jnp.concatenate([kb[..., :-1, :, :], kb[..., 1:, :, :]], axis=-2)
    vw = jnp.concatenate([vb[..., :-1, :, :], vb[..., 1:, :, :]], axis=-2)
    s = jnp.einsum('...nqd,...nkd->...nqk', qb, kw)
    qi = jnp.arange(band)[:, None]
    kj = jnp.arange(2 * band)[None, :]
    dist = band + qi - kj
    kpos = jnp.arange(nb)[:, None, None] * band - band + kj
    valid = (dist >= 0) & (dist <= band) & (kpos >= 0)
    s = jnp.where(valid, s, NEG_INF)
    m = jnp.max(s, -1)
    p = jnp.exp(s - m[..., None])
    l = jnp.sum(p, -1)
    acc = jnp.einsum('...nqk,...nkd->...nqd', p, vw)
    return (acc.reshape(*lead, lp, hd)[..., :L, :],
            m.reshape(*lead, lp)[..., :L],
            l.reshape(*lead, lp)[..., :L])


def dilated_attention(q, k, v):
    B, S, H, hd = q.shape
    accs, ms, ls = [], [], []
    for window, dil in DILATED_PATTERNS:
        L = S // dil
        def split(t):
            return t.reshape(B, L, dil, H, hd).transpose(0, 2, 3, 1, 4)
        acc, m, l = banded_causal_attn(split(q), split(k), split(v), window // dil)
        accs.append(acc.transpose(0, 3, 1, 2, 4).reshape(B, S, H, hd))
        ms.append(m.transpose(0, 3, 1, 2).reshape(B, S, H))
        ls.append(l.transpose(0, 3, 1, 2).reshape(B, S, H))
    m_all = jnp.stack(ms)
    wts = jnp.exp(m_all - jnp.max(m_all, 0))
    num = jnp.einsum('pbsh,pbshd->bshd', wts, jnp.stack(accs))
    den = jnp.sum(wts * jnp.stack(ls), 0)
    return num / den[..., None]


def causal_depthwise_conv(x, w, bias):
    C = x.shape[-1]
    y = lax.conv_general_dilated(x, w.astype(x.dtype)[:, None, :], window_strides=(1,),
                                 padding=[(CONV_WIDTH - 1, 0)],
                                 dimension_numbers=('NWC', 'WIO', 'NWC'),
                                 feature_group_count=C)
    return y + bias.astype(x.dtype)


def rg_lru(x, w_a, b_a, w_x, b_x, lam):
    B, S, R = x.shape
    xb = x.reshape(B, S, REC_BLOCKS, REC_BLOCK)
    r = jax.nn.sigmoid(jnp.einsum('bsnc,ncd->bsnd', xb, w_a.astype(jnp.float32)).reshape(B, S, R) + b_a.astype(jnp.float32))
    i = jax.nn.sigmoid(jnp.einsum('bsnc,ncd->bsnd', xb, w_x.astype(jnp.float32)).reshape(B, S, R) + b_x.astype(jnp.float32))
    log_a = -LRU_C * r * jax.nn.softplus(-lam.astype(jnp.float32))
    a = jnp.exp(log_a)
    bterm = jnp.sqrt(-jnp.expm1(2.0 * log_a)) * (i * x)
    def combine(left, right):
        a1, b1 = left
        a2, b2 = right
        return a1 * a2, a2 * b1 + b2
    _, h = lax.associative_scan(combine, (a, bterm), axis=1)
    return h


def peer(x, wq, keys1, keys2, u, v):
    B, S, D = x.shape
    T = B * S
    xt = x.reshape(T, D)
    q = (xt @ wq).astype(jnp.float32).reshape(T, PEER_HEADS, 2, PEER_HALF)
    s1 = jnp.einsum('thd,kd->thk', q[:, :, 0], keys1.astype(jnp.float32))
    s2 = jnp.einsum('thd,kd->thk', q[:, :, 1], keys2.astype(jnp.float32))
    v1, i1 = lax.top_k(s1, PEER_TOPK)
    v2, i2 = lax.top_k(s2, PEER_TOPK)
    cand_s = (v1[..., :, None] + v2[..., None, :]).reshape(T, PEER_HEADS, PEER_TOPK * PEER_TOPK)
    cand_i = (i1[..., :, None] * PEER_NKEYS + i2[..., None, :]).reshape(T, PEER_HEADS, PEER_TOPK * PEER_TOPK)
    top_s, pos = lax.top_k(cand_s, PEER_TOPK)
    idx = jnp.take_along_axis(cand_i, pos, axis=-1).reshape(T, PEER_HEADS * PEER_TOPK)
    gates = jax.nn.softmax(top_s, axis=-1).reshape(T, PEER_HEADS * PEER_TOPK).astype(x.dtype)
    n_chunks = T // PEER_CHUNK
    E = PEER_HEADS * PEER_TOPK
    def chunk_fn(args):
        xc, ic, gc = args
        uc = jnp.take(u, ic, axis=0)
        act = jax.nn.gelu(jnp.einsum('cd,ced->ce', xc, uc))
        vc = jnp.take(v, ic, axis=0)
        return jnp.einsum('ce,ced->cd', gc * act, vc)
    out = lax.map(chunk_fn, (xt.reshape(n_chunks, PEER_CHUNK, D),
                             idx.reshape(n_chunks, PEER_CHUNK, E),
                             gates.reshape(n_chunks, PEER_CHUNK, E)))
    return out.reshape(B, S, D)


def setup_inputs(seed: int = 0) -> dict:
    key = jax.random.key(seed)
    ks = jax.random.split(key, 24)
    f32 = jnp.float32
    nrm = lambda k, shape, s: jax.random.normal(k, shape, f32) * s
    x = jax.random.normal(ks[0], (BATCH, SEQ, D_MODEL), f32)
    positions = jnp.broadcast_to(jnp.arange(SEQ, dtype=jnp.int32), (BATCH, SEQ))
    col_scale = jnp.concatenate([jnp.ones((2 * ATTN_WIDTH,), f32),
                                 jnp.full((ATTN_WIDTH,), DN_BETA, f32),
                                 jnp.ones((2 * REC_WIDTH,), f32)])
    w_in = nrm(ks[1], (DEPTH, D_MODEL, IN_COLS), D_MODEL ** -0.5) * col_scale
    conv_w = nrm(ks[2], (DEPTH, CONV_WIDTH, REC_WIDTH), CONV_WIDTH ** -0.5)
    conv_b = nrm(ks[3], (DEPTH, REC_WIDTH), 0.01)
    rg_w_a = nrm(ks[4], (DEPTH, REC_BLOCKS, REC_BLOCK, REC_BLOCK), REC_BLOCK ** -0.5)
    rg_b_a = nrm(ks[5], (DEPTH, REC_WIDTH), 0.01)
    rg_w_x = nrm(ks[6], (DEPTH, REC_BLOCKS, REC_BLOCK, REC_BLOCK), REC_BLOCK ** -0.5)
    rg_b_x = nrm(ks[7], (DEPTH, REC_WIDTH), 0.01)
    a_c = jax.random.uniform(ks[8], (DEPTH, REC_WIDTH), f32, 0.9, 0.999)
    a0 = a_c ** (1.0 / LRU_C)
    lru_lambda = jnp.log(a0) - jnp.log1p(-a0)
    gn_attn = 1.0 + nrm(ks[9], (DEPTH, ATTN_WIDTH), 0.01)
    gn_rec = 1.0 + nrm(ks[10], (DEPTH, REC_WIDTH), 0.01)
    w_out = nrm(ks[11], (DEPTH, MIX_WIDTH, D_MODEL), MIX_WIDTH ** -0.5 * DN_BETA)
    ln1_g = 1.0 + nrm(ks[12], (DEPTH, D_MODEL), 0.01)
    ln1_b = nrm(ks[13], (DEPTH, D_MODEL), 0.01)
    peer_wq = nrm(ks[14], (DEPTH, D_MODEL, PEER_HEADS * PEER_QDIM), D_MODEL ** -0.5)
    peer_keys1 = nrm(ks[15], (DEPTH, PEER_NKEYS, PEER_HALF), PEER_HALF ** -0.5)
    peer_keys2 = nrm(ks[16], (DEPTH, PEER_NKEYS, PEER_HALF), PEER_HALF ** -0.5)
    peer_u = nrm(ks[17], (DEPTH, PEER_EXPERTS, D_MODEL), D_MODEL ** -0.5 * DN_BETA)
    peer_v = nrm(ks[18], (DEPTH, PEER_EXPERTS, D_MODEL), DN_BETA)
    ln2_g = 1.0 + nrm(ks[19], (DEPTH, D_MODEL), 0.01)
    ln2_b = nrm(ks[20], (DEPTH, D_MODEL), 0.01)
    return {'x': x, 'positions': positions, 'w_in': w_in, 'conv_w': conv_w, 'conv_b': conv_b,
            'rg_w_a': rg_w_a, 'rg_b_a': rg_b_a, 'rg_w_x': rg_w_x, 'rg_b_x': rg_b_x,
            'lru_lambda': lru_lambda, 'gn_attn': gn_attn, 'gn_rec': gn_rec, 'w_out': w_out,
            'ln1_g': ln1_g, 'ln1_b': ln1_b, 'peer_wq': peer_wq, 'peer_keys1': peer_keys1,
            'peer_keys2': peer_keys2, 'peer_u': peer_u, 'peer_v': peer_v,
            'ln2_g': ln2_g, 'ln2_b': ln2_b}


def reference(x, positions, w_in, conv_w, conv_b, rg_w_a, rg_b_a, rg_w_x, rg_b_x, lru_lambda,
              gn_attn, gn_rec, w_out, ln1_g, ln1_b, peer_wq, peer_keys1, peer_keys2,
              peer_u, peer_v, ln2_g, ln2_b):
    B, S, _ = x.shape
    h = x
    for l in range(DEPTH):
        proj = h @ w_in[l]
        q, k, v, xr, gr = jnp.split(proj, [ATTN_WIDTH, 2 * ATTN_WIDTH, 3 * ATTN_WIDTH,
                                           3 * ATTN_WIDTH + REC_WIDTH], axis=-1)
        q = rope(q.astype(jnp.float32).reshape(B, S, ATTN_HEADS, HEAD_DIM), positions) * (HEAD_DIM ** -0.5)
        k = rope(k.astype(jnp.float32).reshape(B, S, ATTN_HEADS, HEAD_DIM), positions)
        v = v.astype(jnp.float32).reshape(B, S, ATTN_HEADS, HEAD_DIM)
        attn = dilated_attention(q, k, v).reshape(B, S, ATTN_WIDTH)
        xc = causal_depthwise_conv(xr, conv_w[l], conv_b[l]).astype(jnp.float32)
        rec = rg_lru(xc, rg_w_a[l], rg_b_a[l], rg_w_x[l], rg_b_x[l], lru_lambda[l]) \
            * jax.nn.gelu(gr.astype(jnp.float32))
        mix = jnp.concatenate([rms_norm(attn, gn_attn[l]), rms_norm(rec, gn_rec[l])], -1).astype(h.dtype)
        h = layer_norm(DN_ALPHA * h + mix @ w_out[l], ln1_g[l], ln1_b[l])
        y = peer(h, peer_wq[l], peer_keys1[l], peer_keys2[l], peer_u[l], peer_v[l])
        h = layer_norm(DN_ALPHA * h + y, ln2_g[l], ln2_b[l])
    return h
```

```cpp
#include <hip/hip_runtime.h>
#include <cstdio>
#include <cstdint>

namespace pg8 {
#define PG8_LAS __attribute__((address_space(3)))
typedef unsigned short bf16_t;
typedef short bf16x8 __attribute__((ext_vector_type(8)));
typedef float f32x4 __attribute__((ext_vector_type(4)));
typedef unsigned u32x4 __attribute__((ext_vector_type(4)));
constexpr int BM = 256, BK = 64, HALF = 128, HTB = HALF * BK * 2  , STAGE_BYTES = 8 * HTB, NXCD = 8, WGM = 8;

__host__ __device__ __forceinline__ int lds_byte(int r, int c) { const int st = (r >> 4) * 2 + (c >> 5), rr = r & 15, cc = c & 31, ob = rr * 64 + cc * 2; return st * 1024 + (ob ^ (((ob >> 9) & 1) << 5)); }
__host__ __device__ __forceinline__ void stage_rc(int b, int& R, int& C) { const int st = b / 1024, sb = b % 1024, swz = sb ^ (((sb >> 9) & 1) << 5); R = (st >> 1) * 16 + swz / 64; C = (st & 1) * 32 + (swz % 64) / 2; }
__host__ __device__ __forceinline__ int perm32(int rho) { const int n = rho >> 4, i = rho & 15; return 8 * (i >> 2) + 4 * n + (i & 3); }

struct Unit { int pm, pn; };
struct Gemm { const bf16_t* A; const bf16_t* Bt; int M, N, K; };

struct StaticOrder {
    int nM, nN, nwg, G, c;
    __host__ __device__ void init(int M, int N, int G_, int c_) { nM = M / BM; nN = N / BM; nwg = nM * nN; G = G_; c = c_; }
    __host__ __device__ bool next(int i, Unit& u) const {
        const long L = (long)i * G + c; if (L >= nwg) return false;
        int wgid = (int)L; { const int q = nwg / NXCD, r = nwg % NXCD, xcd = wgid % NXCD, off = wgid / NXCD; wgid = (xcd < r ? xcd * (q + 1) : r * (q + 1) + (xcd - r) * q) + off; }
        const int nig = WGM * nN, gid = wgid / nig, fm = gid * WGM, gsz = (nM - fm) < WGM ? (nM - fm) : WGM;
        u.pm = fm + ((wgid % nig) % gsz); u.pn = (wgid % nig) / gsz; return true;
    }
    __device__ __forceinline__ void a_ready(const Unit&) const {}
    __device__ __forceinline__ void done(const Unit&) const {}
};
__device__ __forceinline__ unsigned cvt_pk_bf16(float lo, float hi) { unsigned r; asm volatile("v_cvt_pk_bf16_f32 %0, %1, %2" : "=v"(r) : "v"(lo), "v"(hi)); return r; }
struct EpiF32 {
    static constexpr bool PERM = false, AFTER_DRAIN = false;
    float* C; int ldc;
    __device__ __forceinline__ void operator()(const f32x4 (&acc)[2][2][4][2], const Unit& u, int wr, int wc, int fr, int fq) const {
        const int row0 = u.pm * BM + wr * 64 + fr, col0 = u.pn * BM + wc * 32 + 4 * fq;
#pragma unroll
        for (int ai = 0; ai < 2; ++ai)
#pragma unroll
            for (int m = 0; m < 4; ++m) { float* rowp = C + (size_t)(row0 + ai * HALF + m * 16) * ldc + col0;
#pragma unroll
                for (int bj = 0; bj < 2; ++bj)
#pragma unroll
                    for (int n = 0; n < 2; ++n) *(f32x4*)(rowp + bj * HALF + n * 16) = acc[ai][bj][m][n]; }
    }
    __device__ __forceinline__ void fused(f32x4 (&acc)[2][2][4][2], const Unit& u, int wr, int wc, int fr, int fq, PG8_LAS unsigned char* lds, int wid, int lane) const {}
};
template <class Epi, class Sched, bool ALIGN_EPI = false, bool SP2 = false>
__device__ __forceinline__ void gemm_phase(PG8_LAS unsigned char* lds, const Gemm g, const Sched& S, const Epi& E) {
    const int tid = threadIdx.x, wid = __builtin_amdgcn_readfirstlane(tid >> 6), lane = tid & 63, wr = wid >> 2, wc = wid & 3, fr = lane & 15, fq = lane >> 4;
    const int K = g.K, nt = K / BK;
    unsigned voffA[2], voffB[2];
#pragma unroll
    for (int i = 0; i < 2; ++i) { int R, C; stage_rc(tid * 16 + i * 8192, R, C); const int Rb = Epi::PERM ? ((R & ~31) + perm32(R & 31)) : R;
        voffA[i] = (unsigned)(R * K + C) * 2u; voffB[i] = (unsigned)(Rb * K + C) * 2u; }
    const size_t kstep = (size_t)(BK * 2);
    const size_t hstep = (size_t)HALF * K * 2;
    const size_t tstep = 2 * hstep;
    const unsigned ldsw = (unsigned)wid * 1024u;
    const int aoff = lds_byte(wr * 64 + fr, fq * 8), boff = lds_byte(wc * 32 + fr, fq * 8);
#define PG8_SA(b, h) (((b) * 2 + (h)) * HTB)
#define PG8_SB(b, h) ((4 + (b) * 2 + (h)) * HTB)
#define PG8_STAGE(bufoff, gbase, voff) do { _Pragma("unroll") for (int _i = 0; _i < 2; ++_i) \
        __builtin_amdgcn_global_load_lds((const unsigned*)((const char*)(gbase) + (voff)[_i]), (PG8_LAS unsigned*)(lds + (bufoff) + ldsw + _i * 8192), 16, 0, 0); } while (0)
#define PG8_LDA(dst, b, h) do { _Pragma("unroll") for (int m = 0; m < 4; ++m) _Pragma("unroll") for (int k = 0; k < 2; ++k) dst[m][k] = *(const PG8_LAS bf16x8*)(lds + PG8_SA(b, h) + aoff + m * 2048 + k * 1024); } while (0)
#define PG8_LDB(dst, b, h) do { _Pragma("unroll") for (int n = 0; n < 2; ++n) _Pragma("unroll") for (int k = 0; k < 2; ++k) dst[n][k] = *(const PG8_LAS bf16x8*)(lds + PG8_SB(b, h) + boff + n * 2048 + k * 1024); } while (0)
#define PG8_MMA(ai, bj, At, Bt) do { __builtin_amdgcn_s_setprio(1); _Pragma("unroll") for (int m = 0; m < 4; ++m) _Pragma("unroll") for (int n = 0; n < 2; ++n) _Pragma("unroll") for (int k = 0; k < 2; ++k) \
        acc[ai][bj][m][n] = __builtin_amdgcn_mfma_f32_16x16x32_bf16(Bt[n][k], At[m][k], acc[ai][bj][m][n], 0, 0, 0); __builtin_amdgcn_s_setprio(0); } while (0)
#define PG8_WAIT_V(n) asm volatile("s_waitcnt vmcnt(" #n ")" ::: "memory")
#define PG8_WAIT_L(n) asm volatile("s_waitcnt lgkmcnt(" #n ")" ::: "memory")
#define PG8_BAR __builtin_amdgcn_s_barrier()
#define PG8_SCHED __builtin_amdgcn_sched_barrier(0)
    Unit cur, nxt; int ui = 0;
    if (!S.next(0, cur)) return;
    f32x4 acc[2][2][4][2];
#pragma unroll
    for (int a = 0; a < 2; ++a)
#pragma unroll
        for (int b = 0; b < 2; ++b)
#pragma unroll
            for (int m = 0; m < 4; ++m)
#pragma unroll
                for (int n = 0; n < 2; ++n) acc[a][b][m][n] = (f32x4){0.f, 0.f, 0.f, 0.f};
    bf16x8 At[4][2], B0[2][2], B1[2][2];
    const char* cA = (const char*)g.A + (size_t)cur.pm * tstep; const char* cB = (const char*)g.Bt + (size_t)cur.pn * tstep;
    S.a_ready(cur);
    if constexpr (SP2) {
        PG8_STAGE(PG8_SB(0, 0), cB, voffB); PG8_STAGE(PG8_SB(0, 1), cB + hstep, voffB); PG8_STAGE(PG8_SA(0, 0), cA, voffA); PG8_STAGE(PG8_SA(0, 1), cA + hstep, voffA);
        if (wr == 1) PG8_BAR;
        PG8_WAIT_V(2); PG8_BAR;
        PG8_STAGE(PG8_SB(1, 0), cB + kstep, voffB); PG8_STAGE(PG8_SA(1, 0), cA + kstep, voffA); PG8_STAGE(PG8_SB(1, 1), cB + hstep + kstep, voffB);
        PG8_WAIT_V(6); PG8_BAR;
    } else {
        PG8_STAGE(PG8_SB(0, 0), cB, voffB); PG8_STAGE(PG8_SA(0, 0), cA, voffA); PG8_STAGE(PG8_SB(0, 1), cB + hstep, voffB); PG8_STAGE(PG8_SA(0, 1), cA + hstep, voffA);
        if (wr == 1) PG8_BAR;
        PG8_WAIT_V(4); PG8_BAR;
        PG8_STAGE(PG8_SB(1, 0), cB + kstep, voffB); PG8_STAGE(PG8_SA(1, 0), cA + kstep, voffA); PG8_STAGE(PG8_SB(1, 1), cB + hstep + kstep, voffB);
        PG8_WAIT_V(6); PG8_BAR;
    }
    for (;;) {
        const bool has_next = S.next(ui + 1, nxt);
        const char* nA = has_next ? (const char*)g.A + (size_t)nxt.pm * tstep : cA; const char* nB = has_next ? (const char*)g.Bt + (size_t)nxt.pn * tstep : cB;
        for (int t = 0; t < nt; t += 2) {
            const bool last = (t == nt - 2);
            const char* a1 = cA + (size_t)(t + 1) * kstep;
            const char* a2 = last ? nA : cA + (size_t)(t + 2) * kstep; const char* b2 = last ? nB : cB + (size_t)(t + 2) * kstep;
            const char* a3 = a2 + kstep; const char* b3 = b2 + kstep;
            if (last && has_next) S.a_ready(nxt);
            if constexpr (SP2) {
            PG8_LDB(B0, 0, 0); PG8_LDB(B1, 0, 1); PG8_SCHED; PG8_LDA(At, 0, 0); PG8_STAGE(PG8_SA(1, 1), a1 + hstep, voffA);
            PG8_WAIT_V(8); PG8_WAIT_L(0); PG8_BAR; PG8_MMA(0, 0, At, B0); PG8_MMA(0, 1, At, B1); PG8_BAR; PG8_SCHED;
            PG8_LDA(At, 0, 1); PG8_STAGE(PG8_SB(0, 0), b2, voffB); PG8_STAGE(PG8_SB(0, 1), b2 + hstep, voffB); PG8_STAGE(PG8_SA(0, 0), a2, voffA);
            PG8_WAIT_V(8); PG8_WAIT_L(0); PG8_BAR; PG8_MMA(1, 0, At, B0); PG8_MMA(1, 1, At, B1); PG8_BAR; PG8_SCHED;
            PG8_LDB(B0, 1, 0); PG8_LDB(B1, 1, 1); PG8_SCHED; PG8_LDA(At, 1, 0); PG8_STAGE(PG8_SA(0, 1), a2 + hstep, voffA);
            PG8_WAIT_V(8); PG8_WAIT_L(0); PG8_BAR; PG8_MMA(0, 0, At, B0); PG8_MMA(0, 1, At, B1); PG8_BAR; PG8_SCHED;
            PG8_LDA(At, 1, 1); PG8_STAGE(PG8_SB(1, 0), b3, voffB); PG8_STAGE(PG8_SB(1, 1), b3 + hstep, voffB); PG8_STAGE(PG8_SA(1, 0), a3, voffA);
            PG8_WAIT_V(8); PG8_WAIT_L(0); PG8_BAR; PG8_MMA(1, 0, At, B0); PG8_MMA(1, 1, At, B1); PG8_BAR; PG8_SCHED;
            } else {
            PG8_LDB(B0, 0, 0); PG8_SCHED; PG8_LDA(At, 0, 0); PG8_STAGE(PG8_SA(1, 1), a1 + hstep, voffA);
            PG8_WAIT_L(8); PG8_BAR; PG8_WAIT_L(0); PG8_MMA(0, 0, At, B0); PG8_BAR; PG8_SCHED;
            PG8_LDB(B1, 0, 1); PG8_STAGE(PG8_SB(0, 0), b2, voffB);
            PG8_BAR; PG8_WAIT_L(0); PG8_MMA(0, 1, At, B1); PG8_BAR;
            PG8_LDA(At, 0, 1); PG8_STAGE(PG8_SA(0, 0), a2, voffA);
            PG8_BAR; PG8_WAIT_L(0); PG8_MMA(1, 0, At, B0); PG8_BAR; PG8_SCHED;
            PG8_STAGE(PG8_SB(0, 1), b2 + hstep, voffB);
            PG8_WAIT_V(6); PG8_BAR; PG8_MMA(1, 1, At, B1); PG8_BAR;
            PG8_LDB(B0, 1, 0); PG8_SCHED; PG8_LDA(At, 1, 0); PG8_STAGE(PG8_SA(0, 1), a2 + hstep, voffA);
            PG8_WAIT_L(8); PG8_BAR; PG8_WAIT_L(0); PG8_MMA(0, 0, At, B0); PG8_BAR; PG8_SCHED;
            PG8_LDB(B1, 1, 1); PG8_STAGE(PG8_SB(1, 0), b3, voffB);
            PG8_BAR; PG8_WAIT_L(0); PG8_MMA(0, 1, At, B1); PG8_BAR;
            PG8_LDA(At, 1, 1); PG8_STAGE(PG8_SA(1, 0), a3, voffA);
            PG8_BAR; PG8_WAIT_L(0); PG8_MMA(1, 0, At, B0); PG8_BAR; PG8_SCHED;
            PG8_STAGE(PG8_SB(1, 1), b3 + hstep, voffB);
            PG8_WAIT_V(6); PG8_BAR; PG8_MMA(1, 1, At, B1); PG8_BAR;
            }
        }
        if constexpr (ALIGN_EPI) { if (wr == 0) PG8_BAR; }
        if constexpr (!Epi::AFTER_DRAIN) { E(acc, cur, wr, wc, fr, fq); S.done(cur); }
        if (!has_next) break;
#pragma unroll
        for (int a = 0; a < 2; ++a)
#pragma unroll
            for (int b = 0; b < 2; ++b)
#pragma unroll
                for (int m = 0; m < 4; ++m)
#pragma unroll
                    for (int n = 0; n < 2; ++n) acc[a][b][m][n] = (f32x4){0.f, 0.f, 0.f, 0.f};
        cur = nxt; cA = nA; cB = nB; ++ui;
        if constexpr (ALIGN_EPI) { if (wr == 1) PG8_BAR; }
    }
    PG8_WAIT_V(0);
    if constexpr (!ALIGN_EPI) { if (wr == 0) PG8_BAR; }
    PG8_BAR;
    if constexpr (Epi::AFTER_DRAIN) { E.fused(acc, cur, wr, wc, fr, fq, lds, wid, lane); S.done(cur); }
#undef PG8_SA
#undef PG8_SB
#undef PG8_STAGE
#undef PG8_LDA
#undef PG8_LDB
#undef PG8_MMA
#undef PG8_WAIT_V
#undef PG8_WAIT_L
#undef PG8_BAR
#undef PG8_SCHED
}
}

#ifndef MK_ONE_LAUNCH
#define MK_ONE_LAUNCH 0
#endif
constexpr int NWAVES = 8, NTHR = 512;
constexpr int BATCH = 4, SEQ = 2048, DM = 2048, T = BATCH * SEQ;
constexpr int AW = 1024, RW = 1024, NIN = 5120, NH = 8, HD = 128;
constexpr int PH = 8, NK = 128, TOPK = 16, NE = 128;
constexpr float ALPHA = 1.18920711500272f, LN_EPS = 1e-5f;
constexpr int NPH = 11;
constexpr size_t MiB = 1u << 20;
constexpr size_t WS_CTL = 0, CTL_ZERO_BYTES = 1 * MiB;
constexpr size_t WS_ROPE = 2 * MiB;
constexpr size_t WS_WOUT = 8 * MiB, WS_WQ = 16 * MiB, WS_WIN = 24 * MiB;
constexpr size_t WS_XB = 48 * MiB;
constexpr size_t WS_PROJ = 80 * MiB;
constexpr size_t WS_Q = 240 * MiB, WS_K = 256 * MiB, WS_V = 272 * MiB;
constexpr size_t WS_XC = 288 * MiB, WS_GG = 320 * MiB, WS_ATT = 352 * MiB, WS_AA = 384 * MiB, WS_BB = 416 * MiB, WS_REC = 448 * MiB;
constexpr size_t WS_MIX = 480 * MiB;
constexpr size_t WS_Z = 80 * MiB;
constexpr size_t WS_H1F = 144 * MiB;
constexpr size_t WS_H1B = 208 * MiB;
constexpr size_t WS_Q2 = 240 * MiB;
constexpr size_t WS_IDX = 304 * MiB, WS_GATE = 308 * MiB;
constexpr size_t WS_END = 512 * MiB;
constexpr int CW_BAR = 4096;
constexpr int RING_OFF = 0, RING_BYTES = 131072;
constexpr int LDSCTL_OFF = RING_BYTES, MISC_OFF = LDSCTL_OFF + 320;
constexpr int LDS_BYTES = 147456;

#define GAS __attribute__((address_space(1)))
#define LAS __attribute__((address_space(3)))
typedef unsigned short bf16;
typedef unsigned v4u __attribute__((ext_vector_type(4)));
typedef unsigned v2u __attribute__((ext_vector_type(2)));
typedef float f32x4 __attribute__((ext_vector_type(4)));
typedef GAS unsigned gu32;
#define RLX_AGENT __ATOMIC_RELAXED, __HIP_MEMORY_SCOPE_AGENT
#define LDS_WAIT() asm volatile("s_waitcnt lgkmcnt(0)" ::: "memory")
#define VM_WAIT() asm volatile("s_waitcnt vmcnt(0)" ::: "memory")
__device__ __forceinline__ unsigned f2bf(float f) { unsigned u = __builtin_bit_cast(unsigned, f); return (u + 0x7fffu + ((u >> 16) & 1u)) >> 16; }
__device__ __forceinline__ unsigned pk2(float lo, float hi) { return f2bf(lo) | (f2bf(hi) << 16); }
__device__ __forceinline__ float bf2f(unsigned short b) { return __builtin_bit_cast(float, ((unsigned)b) << 16); }
__device__ __forceinline__ float bflo(unsigned w) { return __builtin_bit_cast(float, w << 16); }
__device__ __forceinline__ float bfhi(unsigned w) { return __builtin_bit_cast(float, w & 0xffff0000u); }
__device__ __forceinline__ float wave_sum(float v) {
#pragma unroll
    for (int o = 1; o < 64; o <<= 1) v += __shfl_xor(v, o);
    return v;
}
__device__ __forceinline__ float wave_max(float v) {
#pragma unroll
    for (int o = 1; o < 64; o <<= 1) v = fmaxf(v, __shfl_xor(v, o));
    return v;
}
__device__ __forceinline__ float gelu_tanh(float x) { const float u = 0.7978845608028654f * (x + 0.044715f * x * x * x); return x / (1.0f + __expf(-2.0f * u)); }
__device__ __forceinline__ float sigmoidf_(float x) { return 1.0f / (1.0f + __expf(-x)); }

#define XB_TMO      128
#define XB_XCNT(j)  (256  + 64 * (j))
#define XB_XSUB(j)  (1280 + 64 * (j))
#define XB_XGEN(j)  (2304 + 64 * (j))
#define XB_TOP      3328
#define XB_TOPGEN   3392
#define XCD_BAR_WORDS 3456
#define XB_SPIN_CAP (1u << 18)

__device__ __forceinline__ unsigned xb_ld(unsigned* p)              { return __hip_atomic_load(p, __ATOMIC_RELAXED, __HIP_MEMORY_SCOPE_AGENT); }
__device__ __forceinline__ unsigned xb_add(unsigned* p, unsigned v) { return __hip_atomic_fetch_add(p, v, __ATOMIC_RELAXED, __HIP_MEMORY_SCOPE_AGENT); }
__device__ __forceinline__ unsigned xb_xcc_id() { return (unsigned)__builtin_amdgcn_s_getreg((3 << 11) | 20) & 0xFu; }
#define XB_SPIN(cond, bar) do { unsigned _sp = 0; while (cond) { __builtin_amdgcn_s_sleep(1); \
    if ((++_sp & 255u) == 0u) { if (xb_ld(&(bar)[XB_TMO])) break; if (_sp > XB_SPIN_CAP) { atomicAdd(&(bar)[XB_TMO], 1u); break; } } } } while (0)

struct XcdBarrier {
    unsigned* bar; unsigned x;
    volatile LAS unsigned* st;
};

__device__ __forceinline__ XcdBarrier xcd_barrier_post(unsigned* bar, volatile LAS unsigned* st) {
    XcdBarrier b; b.bar = bar; b.x = xb_xcc_id(); b.st = st;
    if (threadIdx.x == 0) (void)xb_add(&bar[XB_XCNT(b.x)], 1u);
    return b;
}
__device__ __forceinline__ void xcd_barrier_complete(unsigned* bar, unsigned x, unsigned& nloc, unsigned& nx) {
    const unsigned G = gridDim.x * gridDim.y * gridDim.z;
    unsigned sum, cnt, mine, sp = 0u;
    for (;;) {
        sum = 0u; cnt = 0u; mine = 0u;
#pragma unroll
        for (unsigned j = 0; j < 16; ++j) { const unsigned c = xb_ld(&bar[XB_XCNT(j)]); sum += c; cnt += (c > 0u) ? 1u : 0u; mine = (j == x) ? c : mine; }
        if (sum == G) break;
        __builtin_amdgcn_s_sleep(1);
        if ((++sp & 255u) == 0u) { if (xb_ld(&bar[XB_TMO])) break; if (sp > XB_SPIN_CAP) { atomicAdd(&bar[XB_TMO], 1u); break; } }
    }
    nloc = mine > 0u ? mine : 1u; nx = cnt > 0u ? cnt : 1u;
}

__device__ __forceinline__ void xcd_barrier(const XcdBarrier& b) {
    asm volatile("s_waitcnt vmcnt(0)" ::: "memory");
    __syncthreads();
    if (threadIdx.x == 0) {
        unsigned* bar = b.bar;
        __builtin_amdgcn_s_waitcnt(0);
        unsigned nloc = b.st[0], nx = b.st[1];
        if (nloc == 0u) { xcd_barrier_complete(bar, b.x, nloc, nx); b.st[0] = nloc; b.st[1] = nx; }
        const unsigned old = xb_add(&bar[XB_XSUB(b.x)], 1u);
        const unsigned gen = old / nloc;
        if (old + 1u == (gen + 1u) * nloc) {
            __builtin_amdgcn_fence(__ATOMIC_RELEASE, "agent");
            asm volatile("s_waitcnt vmcnt(0)" ::: "memory");
            const unsigned og = xb_add(&bar[XB_TOP], 1u);
            const unsigned tg = og / nx;
            if (og + 1u == (tg + 1u) * nx) xb_add(&bar[XB_TOPGEN], 1u);
            else XB_SPIN(xb_ld(&bar[XB_TOPGEN]) == tg, bar);
            __builtin_amdgcn_fence(__ATOMIC_ACQUIRE, "agent");
            xb_add(&bar[XB_XGEN(b.x)], 1u);
            asm volatile("s_waitcnt vmcnt(0)" ::: "memory");
        } else {
            XB_SPIN(xb_ld(&bar[XB_XGEN(b.x)]) == gen, bar);
            __builtin_amdgcn_fence(__ATOMIC_ACQUIRE, "agent");
            asm volatile("s_waitcnt vmcnt(0)" ::: "memory");
        }
    }
    __syncthreads();
}


struct Frame {
    LAS unsigned char* lds;
    volatile LAS unsigned* MISC;
    gu32* ctl;
    int tid, lane, wave;
    int vcu, G;
    const float* x; const int* pos; const float* w_in; const float* conv_w; const float* conv_b; const float* w_a; const float* b_a; const float* w_x; const float* b_x;
    const float* lam; const float* gn_attn; const float* gn_rec; const float* w_out; const float* ln1_g; const float* ln1_b; const float* wq; const float* keys1; const float* keys2;
    const float* pu; const float* pv; const float* ln2_g; const float* ln2_b;
    float* out; unsigned char* ws;
};

__device__ __forceinline__ void p0_transpose_item(const float* W, int K, int N, bf16* WT, LAS float* scr, int item, int lane) {
    const int nblk = N / 32, kb = item / nblk, nb = item % nblk, k0 = 64 * kb, n0 = 32 * nb;
#pragma unroll 8
    for (int i = 0; i < 32; ++i) { const int kk = 2 * i + (lane >> 5); scr[kk * 33 + (lane & 31)] = W[(size_t)(k0 + kk) * N + n0 + (lane & 31)]; }
    LDS_WAIT(); asm volatile("" ::: "memory");
    const int c = lane & 7;
#pragma unroll
    for (int j = 0; j < 4; ++j) { const int n = (lane >> 3) + 8 * j; const LAS float* s = scr + (8 * c) * 33 + n;
        v4u o; o.x = pk2(s[0 * 33], s[1 * 33]); o.y = pk2(s[2 * 33], s[3 * 33]); o.z = pk2(s[4 * 33], s[5 * 33]); o.w = pk2(s[6 * 33], s[7 * 33]);
        *(v4u*)(WT + (size_t)(n0 + n) * K + k0 + 8 * c) = o; }
    LDS_WAIT(); asm volatile("" ::: "memory");
}

__device__ __forceinline__ void p0_prep(Frame& F) {
    LAS float* scr = (LAS float*)(F.lds + RING_OFF + F.wave * 16384);
    const int gw = F.vcu * NWAVES + F.wave, NGW = F.G * NWAVES;
    constexpr int I_IN = (DM / 64) * (NIN / 32), I_O = (DM / 64) * (DM / 32), I_Q = I_O;
    bf16* Win_t = (bf16*)(F.ws + WS_WIN); bf16* Wout_t = (bf16*)(F.ws + WS_WOUT); bf16* Wq_t = (bf16*)(F.ws + WS_WQ);
    for (int it = gw; it < I_IN + I_O + I_Q; it += NGW) {
        int r = it;
        if (r < I_IN) { p0_transpose_item(F.w_in, DM, NIN, Win_t, scr, r, F.lane); continue; } r -= I_IN;
        if (r < I_O) { p0_transpose_item(F.w_out, DM, DM, Wout_t, scr, r, F.lane); continue; } r -= I_O;
        p0_transpose_item(F.wq, DM, DM, Wq_t, scr, r, F.lane);
    }
    const size_t gt = (size_t)blockIdx.x * NTHR + F.tid, GT = (size_t)F.G * NTHR;
    {
        const f32x4* x4 = (const f32x4*)F.x; v2u* xb = (v2u*)(F.ws + WS_XB);
        for (size_t i = gt; i < (size_t)T * DM / 4; i += GT) { const f32x4 v = x4[i]; v2u o; o.x = pk2(v.x, v.y); o.y = pk2(v.z, v.w); xb[i] = o; }
    }
    {
        float* ct = (float*)(F.ws + WS_ROPE); float* st = ct + (size_t)T * 64;
        for (size_t i = gt; i < (size_t)T * 64; i += GT) {
            const int tok = (int)(i >> 6), k = (int)(i & 63);
            const float inv = expf(-(float)k * (9.210340371976184f / 64.0f));
            const float ang = (float)F.pos[tok] * inv;
            const double rev = (double)ang * 0.15915494309189535;
            const float fr = (float)(rev - floor(rev));
            ct[i] = __builtin_amdgcn_cosf(fr); st[i] = __builtin_amdgcn_sinf(fr);
        }
    }
}

__device__ __forceinline__ void p2_post(Frame& F) {
    const size_t gt = (size_t)blockIdx.x * NTHR + F.tid, GT = (size_t)F.G * NTHR;
    const float* P = (const float*)(F.ws + WS_PROJ);
    const float* ct = (const float*)(F.ws + WS_ROPE); const float* st = ct + (size_t)T * 64;
    bf16* Q = (bf16*)(F.ws + WS_Q); bf16* K = (bf16*)(F.ws + WS_K); bf16* V = (bf16*)(F.ws + WS_V);
    float* XC = (float*)(F.ws + WS_XC); float* GG = (float*)(F.ws + WS_GG);
    const float qscale = 0.08838834764831845f;
    for (size_t i = gt; i < (size_t)T * 512; i += GT) {
        const int tok = (int)(i >> 9), r = (int)(i & 511), h = r >> 6, k = r & 63;
        const float c = ct[(size_t)tok * 64 + k], s = st[(size_t)tok * 64 + k];
        const float* pr = P + (size_t)tok * NIN + h * 128 + k;
        const float q1 = pr[0], q2 = pr[64], k1 = pr[1024], k2 = pr[1024 + 64];
        Q[(size_t)tok * AW + h * 128 + k] = (bf16)f2bf((q1 * c - q2 * s) * qscale);
        Q[(size_t)tok * AW + h * 128 + 64 + k] = (bf16)f2bf((q2 * c + q1 * s) * qscale);
        K[(size_t)tok * AW + h * 128 + k] = (bf16)f2bf(k1 * c - k2 * s);
        K[(size_t)tok * AW + h * 128 + 64 + k] = (bf16)f2bf(k2 * c + k1 * s);
    }
    for (size_t i = gt; i < (size_t)T * 1024; i += GT) {
        const int tok = (int)(i >> 10), c = (int)(i & 1023), s = tok & (SEQ - 1);
        const float* pr = P + (size_t)tok * NIN;
        V[i] = (bf16)f2bf(pr[2048 + c]);
        float acc = F.conv_b[c];
#pragma unroll
        for (int j = 0; j < 4; ++j) { const int ds = 3 - j; if (s - ds >= 0) acc += F.conv_w[j * RW + c] * P[(size_t)(tok - ds) * NIN + 3072 + c]; }
        XC[i] = acc;
        GG[i] = gelu_tanh(pr[4096 + c]);
    }
}

__device__ __forceinline__ void p3_attn_simple(Frame& F) {
    const bf16* Q = (const bf16*)(F.ws + WS_Q); const bf16* K = (const bf16*)(F.ws + WS_K); const bf16* V = (const bf16*)(F.ws + WS_V);
    float* ATT = (float*)(F.ws + WS_ATT);
    LAS float* qs = (LAS float*)(F.lds + F.wave * 4096);
    LAS float* ps = qs + 128;
    const int lane = F.lane, h = F.wave;
    for (int tok = blockIdx.x; tok < T; tok += F.G) {
        const int t = tok & (SEQ - 1);
        { const unsigned w = *(const unsigned*)(Q + (size_t)tok * AW + h * 128 + 2 * lane); qs[2 * lane] = bflo(w); qs[2 * lane + 1] = bfhi(w); }
        LDS_WAIT(); asm volatile("" ::: "memory");
        float sc[9]; float mx = -3.0e38f;
#pragma unroll
        for (int p = 0; p < 3; ++p) {
            const int d = (p == 0) ? 1 : (p == 1 ? 4 : 16);
#pragma unroll
            for (int r = 0; r < 3; ++r) {
                const int j = lane + 64 * r; const bool valid = (j <= 128) && (t - j * d >= 0);
                float dot = -3.0e38f;
                if (valid) {
                    const v4u* kr = (const v4u*)(K + (size_t)(tok - j * d) * AW + h * 128);
                    float a = 0.f;
#pragma unroll 4
                    for (int c = 0; c < 16; ++c) { const v4u w = kr[c];
                        a += qs[8 * c + 0] * bflo(w.x) + qs[8 * c + 1] * bfhi(w.x) + qs[8 * c + 2] * bflo(w.y) + qs[8 * c + 3] * bfhi(w.y)
                           + qs[8 * c + 4] * bflo(w.z) + qs[8 * c + 5] * bfhi(w.z) + qs[8 * c + 6] * bflo(w.w) + qs[8 * c + 7] * bfhi(w.w); }
                    dot = a;
                }
                sc[p * 3 + r] = dot; mx = fmaxf(mx, dot);
            }
        }
        mx = wave_max(mx);
        float sum = 0.f;
#pragma unroll
        for (int e = 0; e < 9; ++e) { const float pv = (sc[e] > -1.0e38f) ? __expf(sc[e] - mx) : 0.f; sum += pv; ps[e * 64 + lane] = pv; }
        sum = wave_sum(sum);
        LDS_WAIT(); asm volatile("" ::: "memory");
        float a0 = 0.f, a1 = 0.f;
        for (int p = 0; p < 3; ++p) {
            const int d = (p == 0) ? 1 : (p == 1 ? 4 : 16);
            const int jmax = min(128, t / d);
            for (int j = 0; j <= jmax; ++j) {
                const float pj = ps[(p * 3 + (j >> 6)) * 64 + (j & 63)];
                const unsigned w = *(const unsigned*)(V + (size_t)(tok - j * d) * AW + h * 128 + 2 * lane);
                a0 += pj * bflo(w); a1 += pj * bfhi(w);
            }
        }
        const float inv = 1.0f / sum;
        ATT[(size_t)tok * AW + h * 128 + 2 * lane] = a0 * inv; ATT[(size_t)tok * AW + h * 128 + 2 * lane + 1] = a1 * inv;
        LDS_WAIT(); asm volatile("" ::: "memory");
    }
}

__device__ __forceinline__ void p3_gates_simple(Frame& F) {
    const float* XC = (const float*)(F.ws + WS_XC); float* AA = (float*)(F.ws + WS_AA); float* BB = (float*)(F.ws + WS_BB);
    const size_t gt = (size_t)blockIdx.x * NTHR + F.tid, GT = (size_t)F.G * NTHR;
    for (size_t i = gt; i < (size_t)T * RW; i += GT) {
        const int tok = (int)(i >> 10), ch = (int)(i & 1023), n = ch >> 7, dd = ch & 127;
        const float* xr = XC + (size_t)tok * RW + n * 128;
        const float* wa = F.w_a + (size_t)n * 128 * 128 + dd; const float* wx = F.w_x + (size_t)n * 128 * 128 + dd;
        float ga = F.b_a[ch], gx = F.b_x[ch];
#pragma unroll 8
        for (int c = 0; c < 128; ++c) { const float xv = xr[c]; ga += xv * wa[c * 128]; gx += xv * wx[c * 128]; }
        const float r = sigmoidf_(ga), ig = sigmoidf_(gx);
        const float sp = log1pf(expf(-F.lam[ch]));
        const float la = -8.0f * r * sp;
        const float a = expf(la);
        const float bt = sqrtf(-expm1f(2.0f * la)) * (ig * XC[i]);
        AA[i] = a; BB[i] = bt;
    }
}

__device__ __forceinline__ void p4_scan_simple(Frame& F) {
    const float* AA = (const float*)(F.ws + WS_AA); const float* BB = (const float*)(F.ws + WS_BB); const float* GG = (const float*)(F.ws + WS_GG);
    float* REC = (float*)(F.ws + WS_REC);
    const int gt = blockIdx.x * NTHR + F.tid;
    if (F.tid < 64) {
        const int id = blockIdx.x * 64 + F.tid;
        if (id < BATCH * RW) {
            const int b = id >> 10, ch = id & 1023;
            float hst = 0.f; size_t o = (size_t)b * SEQ * RW + ch;
            for (int s = 0; s < SEQ; s += 8) {
                float av[8], bv[8], gv[8];
#pragma unroll
                for (int u = 0; u < 8; ++u) { av[u] = AA[o + (size_t)(s + u) * RW]; bv[u] = BB[o + (size_t)(s + u) * RW]; gv[u] = GG[o + (size_t)(s + u) * RW]; }
#pragma unroll
                for (int u = 0; u < 8; ++u) { hst = av[u] * hst + bv[u]; REC[o + (size_t)(s + u) * RW] = hst * gv[u]; }
            }
        }
    }
    (void)gt;
}

__device__ __forceinline__ void p5_mix(Frame& F) {
    const float* ATT = (const float*)(F.ws + WS_ATT); const float* REC = (const float*)(F.ws + WS_REC); bf16* MIX = (bf16*)(F.ws + WS_MIX);
    const int gw = blockIdx.x * NWAVES + F.wave, NGW = F.G * NWAVES, lane = F.lane;
    for (int tok = gw; tok < T; tok += NGW) {
#pragma unroll
        for (int half = 0; half < 2; ++half) {
            const f32x4* src = (const f32x4*)((half ? REC : ATT) + (size_t)tok * 1024) + lane;
            const f32x4* g4 = (const f32x4*)(half ? F.gn_rec : F.gn_attn) + lane;
            f32x4 v[4]; float ss = 0.f;
#pragma unroll
            for (int j = 0; j < 4; ++j) { v[j] = src[64 * j]; ss += (v[j].x * v[j].x + v[j].y * v[j].y) + (v[j].z * v[j].z + v[j].w * v[j].w); }
            const float rs = 1.0f / sqrtf(wave_sum(ss) * (1.0f / 1024.0f) + LN_EPS);
            v2u* o = (v2u*)(MIX + (size_t)tok * DM + half * 1024) + lane;
#pragma unroll
            for (int j = 0; j < 4; ++j) { const f32x4 g = g4[64 * j]; v2u w; w.x = pk2(v[j].x * rs * g.x, v[j].y * rs * g.y); w.y = pk2(v[j].z * rs * g.z, v[j].w * rs * g.w); o[64 * j] = w; }
        }
    }
}

__device__ __forceinline__ void ln_row(f32x4 (&v)[8], const float* g, const float* b, int lane) {
    float s = 0.f;
#pragma unroll
    for (int j = 0; j < 8; ++j) s += (v[j].x + v[j].y) + (v[j].z + v[j].w);
    const float mean = wave_sum(s) * (1.0f / DM); float s2 = 0.f;
#pragma unroll
    for (int j = 0; j < 8; ++j) { v[j] = v[j] - mean; s2 += (v[j].x * v[j].x + v[j].y * v[j].y) + (v[j].z * v[j].z + v[j].w * v[j].w); }
    const float rstd = 1.0f / sqrtf(wave_sum(s2) * (1.0f / DM) + LN_EPS);
#pragma unroll
    for (int j = 0; j < 8; ++j) { const f32x4 gg = ((const f32x4*)g)[lane + 64 * j], bb = ((const f32x4*)b)[lane + 64 * j]; v[j] = v[j] * rstd * gg + bb; }
}

__device__ __forceinline__ void p7_ln1(Frame& F) {
    const float* Z = (const float*)(F.ws + WS_Z); float* H1F = (float*)(F.ws + WS_H1F); bf16* H1B = (bf16*)(F.ws + WS_H1B);
    const int gw = blockIdx.x * NWAVES + F.wave, NGW = F.G * NWAVES, lane = F.lane;
    for (int tok = gw; tok < T; tok += NGW) {
        const f32x4* z4 = (const f32x4*)(Z + (size_t)tok * DM) + lane; const f32x4* x4 = (const f32x4*)(F.x + (size_t)tok * DM) + lane;
        f32x4 v[8];
#pragma unroll
        for (int j = 0; j < 8; ++j) v[j] = x4[64 * j] * ALPHA + z4[64 * j];
        ln_row(v, F.ln1_g, F.ln1_b, lane);
        f32x4* o4 = (f32x4*)(H1F + (size_t)tok * DM) + lane; v2u* ob = (v2u*)(H1B + (size_t)tok * DM) + lane;
#pragma unroll
        for (int j = 0; j < 8; ++j) { o4[64 * j] = v[j]; v2u w; w.x = pk2(v[j].x, v[j].y); w.y = pk2(v[j].z, v[j].w); ob[64 * j] = w; }
    }
}

__device__ __forceinline__ void p9_topk_simple(Frame& F) {
    const float* Q2 = (const float*)(F.ws + WS_Q2); int* IDX = (int*)(F.ws + WS_IDX); float* GATE = (float*)(F.ws + WS_GATE);
    LAS float* qs = (LAS float*)(F.lds + F.wave * 4096);
    LAS float* tv = qs + 256; LAS int* ti = (LAS int*)(qs + 288);
    const int gw = blockIdx.x * NWAVES + F.wave, NGW = F.G * NWAVES, lane = F.lane;
    for (int it = gw; it < T * PH; it += NGW) {
        const int tok = it >> 3, h = it & 7;
        { const f32x4 v = *((const f32x4*)(Q2 + (size_t)tok * DM + h * 256) + lane); qs[4 * lane] = v.x; qs[4 * lane + 1] = v.y; qs[4 * lane + 2] = v.z; qs[4 * lane + 3] = v.w; }
        LDS_WAIT(); asm volatile("" ::: "memory");
        float s[2][2];
#pragma unroll
        for (int half = 0; half < 2; ++half)
#pragma unroll
            for (int r = 0; r < 2; ++r) {
                const f32x4* kr = (const f32x4*)((half ? F.keys2 : F.keys1) + (size_t)(lane + 64 * r) * 128);
                float a = 0.f;
#pragma unroll 8
                for (int c = 0; c < 32; ++c) { const f32x4 kv = kr[c]; a += qs[half * 128 + 4 * c] * kv.x + qs[half * 128 + 4 * c + 1] * kv.y + qs[half * 128 + 4 * c + 2] * kv.z + qs[half * 128 + 4 * c + 3] * kv.w; }
                s[half][r] = a;
            }
#pragma unroll
        for (int half = 0; half < 2; ++half) {
            float v0 = s[half][0], v1 = s[half][1];
            for (int r = 0; r < TOPK; ++r) {
                const float lm = fmaxf(v0, v1); const float wm = wave_max(lm);
                const unsigned long long bal = __ballot(lm == wm);
                const int owner = __ffsll((long long)bal) - 1;
                if (lane == owner) { int ki; if (v0 == wm) { ki = lane; v0 = -3.0e38f; } else { ki = lane + 64; v1 = -3.0e38f; } tv[half * 16 + r] = wm; ti[half * 16 + r] = ki; }
            }
        }
        LDS_WAIT(); asm volatile("" ::: "memory");
        float cv[4]; int ci[4];
#pragma unroll
        for (int q = 0; q < 4; ++q) { const int c = 4 * lane + q, a = c >> 4, b = c & 15; cv[q] = tv[a] + tv[16 + b]; ci[q] = ti[a] * NK + ti[16 + b]; }
        float myv = 0.f; int myi = 0;
        for (int r = 0; r < TOPK; ++r) {
            const float lm = fmaxf(fmaxf(cv[0], cv[1]), fmaxf(cv[2], cv[3])); const float wm = wave_max(lm);
            const unsigned long long bal = __ballot(lm == wm);
            const int owner = __ffsll((long long)bal) - 1;
            int wi = 0;
            if (lane == owner) {
                if (cv[0] == wm) { wi = ci[0]; cv[0] = -3.0e38f; } else if (cv[1] == wm) { wi = ci[1]; cv[1] = -3.0e38f; } else if (cv[2] == wm) { wi = ci[2]; cv[2] = -3.0e38f; } else { wi = ci[3]; cv[3] = -3.0e38f; }
            }
            wi = __shfl(wi, owner);
            if (lane == r) { myv = wm; myi = wi; }
        }
        const float m0 = __shfl(myv, 0);
        const float e = (lane < TOPK) ? __expf(myv - m0) : 0.f;
        const float es = wave_sum(e);
        if (lane < TOPK) { IDX[(size_t)tok * NE + h * 16 + lane] = myi; GATE[(size_t)tok * NE + h * 16 + lane] = e / es; }
        LDS_WAIT(); asm volatile("" ::: "memory");
    }
}

__device__ __forceinline__ void p10_peer_simple(Frame& F) {
    const float* H1F = (const float*)(F.ws + WS_H1F); const int* IDX = (const int*)(F.ws + WS_IDX); const float* GATE = (const float*)(F.ws + WS_GATE);
    const int gw = blockIdx.x * NWAVES + F.wave, NGW = F.G * NWAVES, lane = F.lane;
    for (int tok = gw; tok < T; tok += NGW) {
        f32x4 xv[8], y[8];
        const f32x4* x4 = (const f32x4*)(H1F + (size_t)tok * DM) + lane;
#pragma unroll
        for (int j = 0; j < 8; ++j) { xv[j] = x4[64 * j]; y[j] = (f32x4){0.f, 0.f, 0.f, 0.f}; }
        for (int e = 0; e < NE; ++e) {
            const int ei = IDX[(size_t)tok * NE + e]; const float g = GATE[(size_t)tok * NE + e];
            const f32x4* u4 = (const f32x4*)(F.pu + (size_t)ei * DM) + lane; const f32x4* v4 = (const f32x4*)(F.pv + (size_t)ei * DM) + lane;
            f32x4 uu[8], vv[8];
#pragma unroll
            for (int j = 0; j < 8; ++j) { uu[j] = u4[64 * j]; vv[j] = v4[64 * j]; }
            float d = 0.f;
#pragma unroll
            for (int j = 0; j < 8; ++j) d += (xv[j].x * uu[j].x + xv[j].y * uu[j].y) + (xv[j].z * uu[j].z + xv[j].w * uu[j].w);
            d = wave_sum(d);
            const float c = g * gelu_tanh(d);
#pragma unroll
            for (int j = 0; j < 8; ++j) y[j] = y[j] + vv[j] * c;
        }
#pragma unroll
        for (int j = 0; j < 8; ++j) y[j] = xv[j] * ALPHA + y[j];
        ln_row(y, F.ln2_g, F.ln2_b, lane);
        f32x4* o4 = (f32x4*)(F.out + (size_t)tok * DM) + lane;
#pragma unroll
        for (int j = 0; j < 8; ++j) o4[64 * j] = y[j];
    }
}

struct Args { const void* in[22]; float* out; unsigned char* ws; int ph_lo, ph_hi; };
__global__ void __launch_bounds__(NWAVES * 64, 2) fwd(Args args) {
    extern __shared__ __attribute__((aligned(16))) unsigned char lds[];
    Frame F;
    F.lds = (LAS unsigned char*)lds;
    F.MISC = (volatile LAS unsigned*)(F.lds + MISC_OFF);
    F.tid = threadIdx.x; F.lane = F.tid & 63; F.wave = __builtin_amdgcn_readfirstlane(F.tid >> 6);
    F.G = gridDim.x; { const int bx = blockIdx.x; F.vcu = (F.G % 8 == 0) ? (bx % 8) * (F.G / 8) + bx / 8 : bx; }
    unsigned char* ws = args.ws; F.ws = ws;
    F.ctl = (gu32*)(ws + WS_CTL);
    F.x = (const float*)args.in[0]; F.pos = (const int*)args.in[1]; F.w_in = (const float*)args.in[2]; F.conv_w = (const float*)args.in[3]; F.conv_b = (const float*)args.in[4];
    F.w_a = (const float*)args.in[5]; F.b_a = (const float*)args.in[6]; F.w_x = (const float*)args.in[7]; F.b_x = (const float*)args.in[8]; F.lam = (const float*)args.in[9];
    F.gn_attn = (const float*)args.in[10]; F.gn_rec = (const float*)args.in[11]; F.w_out = (const float*)args.in[12]; F.ln1_g = (const float*)args.in[13]; F.ln1_b = (const float*)args.in[14];
    F.wq = (const float*)args.in[15]; F.keys1 = (const float*)args.in[16]; F.keys2 = (const float*)args.in[17]; F.pu = (const float*)args.in[18]; F.pv = (const float*)args.in[19];
    F.ln2_g = (const float*)args.in[20]; F.ln2_b = (const float*)args.in[21]; F.out = args.out;
    for (int u = F.tid; u < (LDS_BYTES - LDSCTL_OFF) / 4; u += NWAVES * 64) ((LAS unsigned*)(F.lds + LDSCTL_OFF))[u] = 0u;
    __syncthreads();
    XcdBarrier bar; bar.bar = (unsigned*)(F.ctl + CW_BAR); bar.x = 0; bar.st = nullptr;
    if (MK_ONE_LAUNCH) bar = xcd_barrier_post((unsigned*)(F.ctl + CW_BAR), F.MISC + 8);
    const int lo = args.ph_lo, hi = args.ph_hi;
#define IN(k) (lo <= (k) && (k) < hi)
#define SEAM(k) do { if (MK_ONE_LAUNCH && IN(k) && IN((k) + 1)) xcd_barrier(bar); } while (0)
    if (IN(0)) { p0_prep(F); SEAM(0); }
    if (IN(1)) {
        pg8::Gemm g{(const pg8::bf16_t*)(ws + WS_XB), (const pg8::bf16_t*)(ws + WS_WIN), T, NIN, DM}; pg8::StaticOrder S; S.init(T, NIN, F.G, (int)blockIdx.x);
        pg8::EpiF32 E{(float*)(ws + WS_PROJ), NIN};
        pg8::gemm_phase<pg8::EpiF32, pg8::StaticOrder, true, true>(F.lds + RING_OFF, g, S, E);
        SEAM(1);
    }
    if (IN(2)) { p2_post(F); SEAM(2); }
    if (IN(3)) { p3_attn_simple(F); p3_gates_simple(F); SEAM(3); }
    if (IN(4)) { p4_scan_simple(F); SEAM(4); }
    if (IN(5)) { p5_mix(F); SEAM(5); }
    if (IN(6)) {
        pg8::Gemm g{(const pg8::bf16_t*)(ws + WS_MIX), (const pg8::bf16_t*)(ws + WS_WOUT), T, DM, DM}; pg8::StaticOrder S; S.init(T, DM, F.G, (int)blockIdx.x);
        pg8::EpiF32 E{(float*)(ws + WS_Z), DM};
        pg8::gemm_phase<pg8::EpiF32, pg8::StaticOrder, true, true>(F.lds + RING_OFF, g, S, E);
        SEAM(6);
    }
    if (IN(7)) { p7_ln1(F); SEAM(7); }
    if (IN(8)) {
        pg8::Gemm g{(const pg8::bf16_t*)(ws + WS_H1B), (const pg8::bf16_t*)(ws + WS_WQ), T, DM, DM}; pg8::StaticOrder S; S.init(T, DM, F.G, (int)blockIdx.x);
        pg8::EpiF32 E{(float*)(ws + WS_Q2), DM};
        pg8::gemm_phase<pg8::EpiF32, pg8::StaticOrder, true, true>(F.lds + RING_OFF, g, S, E);
        SEAM(8);
    }
    if (IN(9)) { p9_topk_simple(F); SEAM(9); }
    if (IN(10)) { p10_peer_simple(F); }
#undef IN
#undef SEAM
}

extern "C" void kernel_launch(void* const* d_in, const int* in_sizes, int n_in, void* d_out, int out_size, void* d_ws, size_t ws_size, hipStream_t stream) {
    static int grid = 0;
    if (grid == 0) {
        if (n_in != 22 || out_size != T * DM || ws_size < WS_END) { fprintf(stderr, "kernel_launch: unexpected shapes: n_in %d out %d ws %zu\n", n_in, out_size, ws_size); grid = -1; return; }
        int dev = 0, cus = 0, per_cu = 0;
        if (hipGetDevice(&dev) != hipSuccess || hipDeviceGetAttribute(&cus, hipDeviceAttributeMultiprocessorCount, dev) != hipSuccess) { grid = -1; return; }
        if (hipFuncSetAttribute((const void*)fwd, hipFuncAttributeMaxDynamicSharedMemorySize, LDS_BYTES) != hipSuccess) { fprintf(stderr, "kernel_launch: hipFuncSetAttribute failed\n"); grid = -1; return; }
        if (hipOccupancyMaxActiveBlocksPerMultiprocessor(&per_cu, (const void*)fwd, NWAVES * 64, LDS_BYTES) != hipSuccess || per_cu < 1) fprintf(stderr, "kernel_launch: occupancy query reports %d\n", per_cu);
        (void)hipGetLastError();
        grid = cus;
    }
    if (grid < 0) return;
    if (hipMemsetAsync((char*)d_ws + WS_CTL, 0, CTL_ZERO_BYTES, stream) != hipSuccess) return;
    Args a{};
    for (int i = 0; i < 22; ++i) a.in[i] = d_in[i];
    a.out = (float*)d_out; a.ws = (unsigned char*)d_ws;
#if MK_ONE_LAUNCH
    a.ph_lo = 0; a.ph_hi = NPH;
    hipLaunchKernelGGL(fwd, dim3(grid), dim3(NWAVES * 64), LDS_BYTES, stream, a);
#else
    for (int p = 0; p < NPH; ++p) { a.ph_lo = p; a.ph_hi = p + 1; hipLaunchKernelGGL(fwd, dim3(grid), dim3(NWAVES * 64), LDS_BYTES, stream, a); }
#endif
}
```

```cpp
#include <hip/hip_runtime.h>
#include <cstdio>
#include <cstdint>
namespace pg8 {
#define PG8_LAS __attribute__((address_space(3)))
typedef unsigned short bf16_t;
typedef short bf16x8 __attribute__((ext_vector_type(8)));
typedef float f32x4 __attribute__((ext_vector_type(4)));
typedef unsigned u32x4 __attribute__((ext_vector_type(4)));
constexpr int BM = 256, BK = 64, HALF = 128, HTB = HALF * BK * 2  , STAGE_BYTES = 8 * HTB, NXCD = 8, WGM = 8;

__host__ __device__ __forceinline__ int lds_byte(int r, int c) { const int st = (r >> 4) * 2 + (c >> 5), rr = r & 15, cc = c & 31, ob = rr * 64 + cc * 2; return st * 1024 + (ob ^ (((ob >> 9) & 1) << 5)); }
__host__ __device__ __forceinline__ void stage_rc(int b, int& R, int& C) { const int st = b / 1024, sb = b % 1024, swz = sb ^ (((sb >> 9) & 1) << 5); R = (st >> 1) * 16 + swz / 64; C = (st & 1) * 32 + (swz % 64) / 2; }
__host__ __device__ __forceinline__ int perm32(int rho) { const int n = rho >> 4, i = rho & 15; return 8 * (i >> 2) + 4 * n + (i & 3); }

struct Unit { int pm, pn; };
struct Gemm { const bf16_t* A; const bf16_t* Bt; int M, N, K; };

struct StaticOrder {
    int nM, nN, nwg, G, c;
    __host__ __device__ void init(int M, int N, int G_, int c_) { nM = M / BM; nN = N / BM; nwg = nM * nN; G = G_; c = c_; }
    __host__ __device__ bool next(int i, Unit& u) const {
        const long L = (long)i * G + c; if (L >= nwg) return false;
        int wgid = (int)L; { const int q = nwg / NXCD, r = nwg % NXCD, xcd = wgid % NXCD, off = wgid / NXCD; wgid = (xcd < r ? xcd * (q + 1) : r * (q + 1) + (xcd - r) * q) + off; }
        const int nig = WGM * nN, gid = wgid / nig, fm = gid * WGM, gsz = (nM - fm) < WGM ? (nM - fm) : WGM;
        u.pm = fm + ((wgid % nig) % gsz); u.pn = (wgid % nig) / gsz; return true;
    }
    __device__ __forceinline__ void a_ready(const Unit&) const {}
    __device__ __forceinline__ void done(const Unit&) const {}
};
__device__ __forceinline__ unsigned cvt_pk_bf16(float lo, float hi) { unsigned r; asm volatile("s_nop 1\n\tv_cvt_pk_bf16_f32 %0, %1, %2" : "=v"(r) : "v"(lo), "v"(hi)); return r; }
struct EpiF32 {
    static constexpr bool PERM = false, AFTER_DRAIN = false;
    float* C; int ldc;
    __device__ __forceinline__ void operator()(const f32x4 (&acc)[2][2][4][2], const Unit& u, int wr, int wc, int fr, int fq) const {
        const int row0 = u.pm * BM + wr * 64 + fr, col0 = u.pn * BM + wc * 32 + 4 * fq;
#pragma unroll
        for (int ai = 0; ai < 2; ++ai)
#pragma unroll
            for (int m = 0; m < 4; ++m) { float* rowp = C + (size_t)(row0 + ai * HALF + m * 16) * ldc + col0;
#pragma unroll
                for (int bj = 0; bj < 2; ++bj)
#pragma unroll
                    for (int n = 0; n < 2; ++n) *(f32x4*)(rowp + bj * HALF + n * 16) = acc[ai][bj][m][n]; }
    }
    __device__ __forceinline__ void fused(f32x4 (&acc)[2][2][4][2], const Unit& u, int wr, int wc, int fr, int fq, PG8_LAS unsigned char* lds, int wid, int lane) const {}
};

__device__ __forceinline__ float gelu_tanh_e(float x) { const float u = 0.7978845608028654f * (x + 0.044715f * x * x * x); return x / (1.0f + __expf(-2.0f * u)); }
struct EpiProj {
    static constexpr bool PERM = true, AFTER_DRAIN = false;
    bf16_t* O; size_t sec_stride; const float* ct; const float* st; float scale0;
    __device__ __forceinline__ void operator()(const f32x4 (&acc)[2][2][4][2], const Unit& u, int wr, int wc, int fr, int fq) const {
        const int row0 = u.pm * BM + wr * 64 + fr; const int sec = u.pn >> 2; const int col0 = (u.pn & 3) * BM + wc * 32 + 8 * fq;
        bf16_t* base = O + (size_t)sec * sec_stride;
        const int g4 = 4 * (4 * wc + fq);
#pragma unroll
        for (int ai = 0; ai < 2; ++ai)
#pragma unroll
            for (int m = 0; m < 4; ++m) { const int row = row0 + ai * HALF + m * 16; bf16_t* rowp = base + (size_t)row * 1024 + col0;
                f32x4 c4 = (f32x4){1.f, 1.f, 1.f, 1.f}, s4 = (f32x4){0.f, 0.f, 0.f, 0.f};
                if (sec < 2) { c4 = *(const f32x4*)(ct + (size_t)row * 64 + g4); s4 = *(const f32x4*)(st + (size_t)row * 64 + g4); }
#pragma unroll
                for (int bj = 0; bj < 2; ++bj) { f32x4 v0 = acc[ai][bj][m][0], v1 = acc[ai][bj][m][1];
                    if (sec < 2) { const f32x4 o0 = v0 * c4 - v1 * s4, o1 = v1 * c4 + v0 * s4; const float sc = (sec == 0) ? scale0 : 1.0f; v0 = o0 * sc; v1 = o1 * sc; }
                    if (sec == 4) { v0 = (f32x4){gelu_tanh_e(v0[0]), gelu_tanh_e(v0[1]), gelu_tanh_e(v0[2]), gelu_tanh_e(v0[3])}; v1 = (f32x4){gelu_tanh_e(v1[0]), gelu_tanh_e(v1[1]), gelu_tanh_e(v1[2]), gelu_tanh_e(v1[3])}; }
                    u32x4 w; w.x = cvt_pk_bf16(v0[0], v0[1]); w.y = cvt_pk_bf16(v0[2], v0[3]); w.z = cvt_pk_bf16(v1[0], v1[1]); w.w = cvt_pk_bf16(v1[2], v1[3]);
                    *(u32x4*)(rowp + bj * HALF) = w; } }
    }
    __device__ __forceinline__ void fused(f32x4 (&acc)[2][2][4][2], const Unit& u, int wr, int wc, int fr, int fq, PG8_LAS unsigned char* lds, int wid, int lane) const {}
};

struct PanelStats8 {
    unsigned* xbuf;
    unsigned* cnt;
    float eps;
    __device__ __forceinline__ void run(const f32x4 (&v)[2][2][4][2], const Unit& u, int wr, int wc, int fr, int fq, PG8_LAS unsigned char* lds, int wid, int lane) const {
        typedef float f32x2v __attribute__((ext_vector_type(2)));
        PG8_LAS f32x2v* P = (PG8_LAS f32x2v*)lds;
        PG8_LAS f32x2v* S = (PG8_LAS f32x2v*)(lds + 8192);
#pragma unroll
        for (int ai = 0; ai < 2; ++ai)
#pragma unroll
            for (int m = 0; m < 4; ++m) {
                float s = 0.f;
#pragma unroll
                for (int bj = 0; bj < 2; ++bj)
#pragma unroll
                    for (int n = 0; n < 2; ++n) { const f32x4 x = v[ai][bj][m][n]; s += (x[0] + x[1]) + (x[2] + x[3]); }
                s += __shfl_xor(s, 16); s += __shfl_xor(s, 32);
                const float mw = s * (1.0f / 64.0f); float q = 0.f;
#pragma unroll
                for (int bj = 0; bj < 2; ++bj)
#pragma unroll
                    for (int n = 0; n < 2; ++n) { const f32x4 d = v[ai][bj][m][n] - mw; q += (d[0] * d[0] + d[1] * d[1]) + (d[2] * d[2] + d[3] * d[3]); }
                q += __shfl_xor(q, 16); q += __shfl_xor(q, 32);
                if (fq == 0) P[(ai * HALF + wr * 64 + m * 16 + fr) * 4 + wc] = (f32x2v){mw, q};
            }
        asm volatile("s_waitcnt lgkmcnt(0)" ::: "memory"); __builtin_amdgcn_s_barrier(); asm volatile("" ::: "memory");
        const int row = wid * 32 + (lane & 31);
        if (lane < 32) {
            const f32x2v a = P[row * 4 + 0], b = P[row * 4 + 1], c = P[row * 4 + 2], d = P[row * 4 + 3];
            const float mt = (a.x + b.x + c.x + d.x) * 0.25f;
            const float da = a.x - mt, db = b.x - mt, dc = c.x - mt, dd = d.x - mt;
            const float m2 = (a.y + b.y) + (c.y + d.y) + 64.0f * ((da * da + db * db) + (dc * dc + dd * dd));
            unsigned long long* slot = (unsigned long long*)xbuf + ((size_t)(u.pm * 8 + u.pn) * BM + row);
            __hip_atomic_store(slot, ((unsigned long long)__float_as_uint(m2) << 32) | __float_as_uint(mt), __ATOMIC_RELAXED, __HIP_MEMORY_SCOPE_AGENT);
        }
        asm volatile("s_waitcnt vmcnt(0)" ::: "memory");
        if (lane == 0) __hip_atomic_fetch_add(cnt + 64 * u.pm, 1u, __ATOMIC_RELAXED, __HIP_MEMORY_SCOPE_AGENT);
        if (wid == 0) {
            unsigned spins = 0;
            while ((unsigned)__builtin_amdgcn_readfirstlane(__hip_atomic_load(cnt + 64 * u.pm, __ATOMIC_RELAXED, __HIP_MEMORY_SCOPE_AGENT)) < 64u) { __builtin_amdgcn_s_sleep(2); if (++spins > (1u << 22)) break; }
            __builtin_amdgcn_fence(__ATOMIC_ACQUIRE, "agent");
        }
        asm volatile("s_waitcnt vmcnt(0) lgkmcnt(0)" ::: "memory"); __builtin_amdgcn_s_barrier(); asm volatile("" ::: "memory");
        if (lane < 32) {
            const unsigned long long* slot = (const unsigned long long*)xbuf + (size_t)(u.pm * 8) * BM + row; float mt[8], m2[8]; float ms = 0.f;
#pragma unroll
            for (int t = 0; t < 8; ++t) { const unsigned long long w = __hip_atomic_load(slot + t * BM, __ATOMIC_RELAXED, __HIP_MEMORY_SCOPE_AGENT); mt[t] = __uint_as_float((unsigned)w); m2[t] = __uint_as_float((unsigned)(w >> 32)); ms += mt[t]; }
            const float mean = ms * 0.125f; float q = 0.f;
#pragma unroll
            for (int t = 0; t < 8; ++t) { const float dm = mt[t] - mean; q += m2[t] + 256.0f * dm * dm; }
            S[row] = (f32x2v){mean, 1.0f / sqrtf(q * (1.0f / 2048.0f) + eps)};
        }
        asm volatile("s_waitcnt lgkmcnt(0)" ::: "memory"); __builtin_amdgcn_s_barrier(); asm volatile("" ::: "memory");
    }
};
struct EpiResLn {
    static constexpr bool PERM = false, AFTER_DRAIN = true;
    unsigned char* ws; int ptab_off, i_resid, i_g, i_b; size_t off_hb, off_hq, off_xch, off_cnt, off_xb; float alpha, eps;
    __device__ __forceinline__ const float* tabptr(PG8_LAS unsigned char* lds, int k) const {
        volatile PG8_LAS unsigned* t = (volatile PG8_LAS unsigned*)(lds + ptab_off) + 2 * k;
        const unsigned lo = (unsigned)__builtin_amdgcn_readfirstlane((int)t[0]), hi = (unsigned)__builtin_amdgcn_readfirstlane((int)t[1]);
        return (const float*)(((unsigned long long)hi << 32) | lo);
    }
    __device__ __forceinline__ void operator()(const f32x4 (&acc)[2][2][4][2], const Unit& u, int wr, int wc, int fr, int fq) const {}
    __device__ __forceinline__ void fused(f32x4 (&acc)[2][2][4][2], const Unit& u, int wr, int wc, int fr, int fq, PG8_LAS unsigned char* lds, int wid, int lane) const {
        typedef float f32x2v __attribute__((ext_vector_type(2))); typedef unsigned u32x2v __attribute__((ext_vector_type(2)));
        const PG8_LAS f32x2v* S = (const PG8_LAS f32x2v*)(lds + 8192);
        const int col0 = u.pn * BM + wc * 32 + 4 * fq;
        const int vo = (u.pm * BM + wr * 64 + fr) * 2048 + col0;
        {   const bf16_t* resid = (const bf16_t*)(ws + off_xb) + vo;
            typedef unsigned u32x2r __attribute__((ext_vector_type(2)));
#pragma unroll
            for (int ai = 0; ai < 2; ++ai)
#pragma unroll
                for (int m = 0; m < 4; ++m) { const bf16_t* rp = resid + (ai * HALF + m * 16) * 2048;
#pragma unroll
                    for (int bj = 0; bj < 2; ++bj) { const u32x2r w0 = *(const u32x2r*)(rp + bj * HALF), w1 = *(const u32x2r*)(rp + bj * HALF + 16);
                        const f32x4 r0 = (f32x4){__uint_as_float(w0.x << 16), __uint_as_float(w0.x & 0xffff0000u), __uint_as_float(w0.y << 16), __uint_as_float(w0.y & 0xffff0000u)};
                        const f32x4 r1 = (f32x4){__uint_as_float(w1.x << 16), __uint_as_float(w1.x & 0xffff0000u), __uint_as_float(w1.y << 16), __uint_as_float(w1.y & 0xffff0000u)};
                        acc[ai][bj][m][0] += r0 * alpha; acc[ai][bj][m][1] += r1 * alpha; }
                    asm volatile("" : "+v"(acc[ai][0][m][0]), "+v"(acc[ai][0][m][1]), "+v"(acc[ai][1][m][0]), "+v"(acc[ai][1][m][1]));
                    asm volatile("" ::: "memory"); } }
        { const PanelStats8 st{(unsigned*)(ws + off_xch), (unsigned*)(ws + off_cnt), eps}; st.run(acc, u, wr, wc, fr, fq, lds, wid, lane); }
        const float* g = tabptr(lds, i_g); const float* b = tabptr(lds, i_b);
        const __amdgpu_buffer_rsrc_t rsW = __builtin_amdgcn_make_buffer_rsrc((void*)ws, (short)0, 512 << 20, 0x00020000);
#pragma unroll
        for (int bj = 0; bj < 2; ++bj) {
            const f32x4 g0 = *(const f32x4*)(g + col0 + bj * HALF), g1 = *(const f32x4*)(g + col0 + bj * HALF + 16), b0 = *(const f32x4*)(b + col0 + bj * HALF), b1 = *(const f32x4*)(b + col0 + bj * HALF + 16);
#pragma unroll
            for (int ai = 0; ai < 2; ++ai)
#pragma unroll
                for (int m = 0; m < 4; ++m) { const int r = ai * HALF + wr * 64 + m * 16 + fr; const f32x2v sr = S[r]; const int so = (ai * HALF + m * 16) * 2048;
                    const f32x4 h0 = (acc[ai][bj][m][0] - sr.x) * sr.y * g0 + b0, h1 = (acc[ai][bj][m][1] - sr.x) * sr.y * g1 + b1;
                    u32x2v w0; w0.x = cvt_pk_bf16(h0[0], h0[1]); w0.y = cvt_pk_bf16(h0[2], h0[3]); u32x2v w1; w1.x = cvt_pk_bf16(h1[0], h1[1]); w1.y = cvt_pk_bf16(h1[2], h1[3]);
                    __builtin_amdgcn_raw_buffer_store_b64(w0, rsW, vo * 2 + bj * 256, (int)off_hb + so * 2, 0);
                    __builtin_amdgcn_raw_buffer_store_b64(w1, rsW, vo * 2 + bj * 256 + 32, (int)off_hb + so * 2, 0);
                    const float qs = 127.0f / 8.0f;
                    const f32x4 c0 = __builtin_elementwise_min(__builtin_elementwise_max(h0 * qs, (f32x4){-127.f, -127.f, -127.f, -127.f}), (f32x4){127.f, 127.f, 127.f, 127.f});
                    const f32x4 c1 = __builtin_elementwise_min(__builtin_elementwise_max(h1 * qs, (f32x4){-127.f, -127.f, -127.f, -127.f}), (f32x4){127.f, 127.f, 127.f, 127.f});
                    const unsigned q0 = ((unsigned)(int)rintf(c0[0]) & 255u) | (((unsigned)(int)rintf(c0[1]) & 255u) << 8) | (((unsigned)(int)rintf(c0[2]) & 255u) << 16) | (((unsigned)(int)rintf(c0[3]) & 255u) << 24);
                    const unsigned q1 = ((unsigned)(int)rintf(c1[0]) & 255u) | (((unsigned)(int)rintf(c1[1]) & 255u) << 8) | (((unsigned)(int)rintf(c1[2]) & 255u) << 16) | (((unsigned)(int)rintf(c1[3]) & 255u) << 24);
                    __builtin_amdgcn_raw_buffer_store_b32(q0, rsW, vo + bj * 128, (int)off_hq + so, 0);
                    __builtin_amdgcn_raw_buffer_store_b32(q1, rsW, vo + bj * 128 + 16, (int)off_hq + so, 0);
                    asm volatile("" ::: "memory"); }
        }
    }
};

struct EpiBf16Plain {
    static constexpr bool PERM = true, AFTER_DRAIN = false;
    bf16_t* O; int ldc;
    __device__ __forceinline__ void operator()(const f32x4 (&acc)[2][2][4][2], const Unit& u, int wr, int wc, int fr, int fq) const {
        const int row0 = u.pm * BM + wr * 64 + fr, col0 = u.pn * BM + wc * 32 + 8 * fq;
#pragma unroll
        for (int ai = 0; ai < 2; ++ai)
#pragma unroll
            for (int m = 0; m < 4; ++m) { bf16_t* rowp = O + (size_t)(row0 + ai * HALF + m * 16) * ldc + col0;
#pragma unroll
                for (int bj = 0; bj < 2; ++bj) { const f32x4 v0 = acc[ai][bj][m][0], v1 = acc[ai][bj][m][1];
                    u32x4 w; w.x = cvt_pk_bf16(v0[0], v0[1]); w.y = cvt_pk_bf16(v0[2], v0[3]); w.z = cvt_pk_bf16(v1[0], v1[1]); w.w = cvt_pk_bf16(v1[2], v1[3]);
                    *(u32x4*)(rowp + bj * HALF) = w; } }
    }
    __device__ __forceinline__ void fused(f32x4 (&acc)[2][2][4][2], const Unit& u, int wr, int wc, int fr, int fq, PG8_LAS unsigned char* lds, int wid, int lane) const {}
};
template <class Epi, class Sched, bool ALIGN_EPI = false, bool SP2 = false>
__device__ __forceinline__ void gemm_phase(PG8_LAS unsigned char* lds, const Gemm g, const Sched& S, const Epi& E) {
    const int tid = threadIdx.x, wid = __builtin_amdgcn_readfirstlane(tid >> 6), lane = tid & 63, wr = wid >> 2, wc = wid & 3, fr = lane & 15, fq = lane >> 4;
    const int K = g.K, nt = K / BK;
    unsigned voffA[2], voffB[2];
#pragma unroll
    for (int i = 0; i < 2; ++i) { int R, C; stage_rc(tid * 16 + i * 8192, R, C); const int Rb = Epi::PERM ? ((R & ~31) + perm32(R & 31)) : R;
        voffA[i] = (unsigned)(R * K + C) * 2u; voffB[i] = (unsigned)(Rb * K + C) * 2u; }
    const size_t kstep = (size_t)(BK * 2);
    const size_t hstep = (size_t)HALF * K * 2;
    const size_t tstep = 2 * hstep;
    const unsigned ldsw = (unsigned)wid * 1024u;
    const int aoff = lds_byte(wr * 64 + fr, fq * 8), boff = lds_byte(wc * 32 + fr, fq * 8);
#define PG8_SA(b, h) (((b) * 2 + (h)) * HTB)
#define PG8_SB(b, h) ((4 + (b) * 2 + (h)) * HTB)
#define PG8_STAGE(bufoff, gbase, voff) do { _Pragma("unroll") for (int _i = 0; _i < 2; ++_i) \
        __builtin_amdgcn_global_load_lds((const unsigned*)((const char*)(gbase) + (voff)[_i]), (PG8_LAS unsigned*)(lds + (bufoff) + ldsw + _i * 8192), 16, 0, 0); } while (0)
#define PG8_LDA(dst, b, h) do { _Pragma("unroll") for (int m = 0; m < 4; ++m) _Pragma("unroll") for (int k = 0; k < 2; ++k) dst[m][k] = *(const PG8_LAS bf16x8*)(lds + PG8_SA(b, h) + aoff + m * 2048 + k * 1024); } while (0)
#define PG8_LDB(dst, b, h) do { _Pragma("unroll") for (int n = 0; n < 2; ++n) _Pragma("unroll") for (int k = 0; k < 2; ++k) dst[n][k] = *(const PG8_LAS bf16x8*)(lds + PG8_SB(b, h) + boff + n * 2048 + k * 1024); } while (0)
#define PG8_MMA(ai, bj, At, Bt) do { __builtin_amdgcn_s_setprio(1); _Pragma("unroll") for (int m = 0; m < 4; ++m) _Pragma("unroll") for (int n = 0; n < 2; ++n) _Pragma("unroll") for (int k = 0; k < 2; ++k) \
        acc[ai][bj][m][n] = __builtin_amdgcn_mfma_f32_16x16x32_bf16(Bt[n][k], At[m][k], acc[ai][bj][m][n], 0, 0, 0); __builtin_amdgcn_s_setprio(0); } while (0)
#define PG8_WAIT_V(n) asm volatile("s_waitcnt vmcnt(" #n ")" ::: "memory")
#define PG8_WAIT_L(n) asm volatile("s_waitcnt lgkmcnt(" #n ")" ::: "memory")
#define PG8_BAR __builtin_amdgcn_s_barrier()
#define PG8_SCHED __builtin_amdgcn_sched_barrier(0)
    Unit cur, nxt; int ui = 0;
    if (!S.next(0, cur)) return;
    f32x4 acc[2][2][4][2];
#pragma unroll
    for (int a = 0; a < 2; ++a)
#pragma unroll
        for (int b = 0; b < 2; ++b)
#pragma unroll
            for (int m = 0; m < 4; ++m)
#pragma unroll
                for (int n = 0; n < 2; ++n) acc[a][b][m][n] = (f32x4){0.f, 0.f, 0.f, 0.f};
    bf16x8 At[4][2], B0[2][2], B1[2][2];
    const char* cA = (const char*)g.A + (size_t)cur.pm * tstep; const char* cB = (const char*)g.Bt + (size_t)cur.pn * tstep;
    S.a_ready(cur);
    if constexpr (SP2) {
        PG8_STAGE(PG8_SB(0, 0), cB, voffB); PG8_STAGE(PG8_SB(0, 1), cB + hstep, voffB); PG8_STAGE(PG8_SA(0, 0), cA, voffA); PG8_STAGE(PG8_SA(0, 1), cA + hstep, voffA);
        if (wr == 1) PG8_BAR;
        PG8_WAIT_V(2); PG8_BAR;
        PG8_STAGE(PG8_SB(1, 0), cB + kstep, voffB); PG8_STAGE(PG8_SA(1, 0), cA + kstep, voffA); PG8_STAGE(PG8_SB(1, 1), cB + hstep + kstep, voffB);
        PG8_WAIT_V(6); PG8_BAR;
    } else {
        PG8_STAGE(PG8_SB(0, 0), cB, voffB); PG8_STAGE(PG8_SA(0, 0), cA, voffA); PG8_STAGE(PG8_SB(0, 1), cB + hstep, voffB); PG8_STAGE(PG8_SA(0, 1), cA + hstep, voffA);
        if (wr == 1) PG8_BAR;
        PG8_WAIT_V(4); PG8_BAR;
        PG8_STAGE(PG8_SB(1, 0), cB + kstep, voffB); PG8_STAGE(PG8_SA(1, 0), cA + kstep, voffA); PG8_STAGE(PG8_SB(1, 1), cB + hstep + kstep, voffB);
        PG8_WAIT_V(6); PG8_BAR;
    }
    for (;;) {
        const bool has_next = S.next(ui + 1, nxt);
        const char* nA = has_next ? (const char*)g.A + (size_t)nxt.pm * tstep : cA; const char* nB = has_next ? (const char*)g.Bt + (size_t)nxt.pn * tstep : cB;
        for (int t = 0; t < nt; t += 2) {
            const bool last = (t == nt - 2);
            const char* a1 = cA + (size_t)(t + 1) * kstep;
            const char* a2 = last ? nA : cA + (size_t)(t + 2) * kstep; const char* b2 = last ? nB : cB + (size_t)(t + 2) * kstep;
            const char* a3 = a2 + kstep; const char* b3 = b2 + kstep;
            if (last && has_next) S.a_ready(nxt);
            if constexpr (SP2) {
            PG8_LDB(B0, 0, 0); PG8_LDB(B1, 0, 1); PG8_SCHED; PG8_LDA(At, 0, 0); PG8_STAGE(PG8_SA(1, 1), a1 + hstep, voffA);
            PG8_WAIT_V(8); PG8_WAIT_L(0); PG8_BAR; PG8_MMA(0, 0, At, B0); PG8_MMA(0, 1, At, B1); PG8_BAR; PG8_SCHED;
            PG8_LDA(At, 0, 1); PG8_STAGE(PG8_SB(0, 0), b2, voffB); PG8_STAGE(PG8_SB(0, 1), b2 + hstep, voffB); PG8_STAGE(PG8_SA(0, 0), a2, voffA);
            PG8_WAIT_V(8); PG8_WAIT_L(0); PG8_BAR; PG8_MMA(1, 0, At, B0); PG8_MMA(1, 1, At, B1); PG8_BAR; PG8_SCHED;
            PG8_LDB(B0, 1, 0); PG8_LDB(B1, 1, 1); PG8_SCHED; PG8_LDA(At, 1, 0); PG8_STAGE(PG8_SA(0, 1), a2 + hstep, voffA);
            PG8_WAIT_V(8); PG8_WAIT_L(0); PG8_BAR; PG8_MMA(0, 0, At, B0); PG8_MMA(0, 1, At, B1); PG8_BAR; PG8_SCHED;
            PG8_LDA(At, 1, 1); PG8_STAGE(PG8_SB(1, 0), b3, voffB); PG8_STAGE(PG8_SB(1, 1), b3 + hstep, voffB); PG8_STAGE(PG8_SA(1, 0), a3, voffA);
            PG8_WAIT_V(8); PG8_WAIT_L(0); PG8_BAR; PG8_MMA(1, 0, At, B0); PG8_MMA(1, 1, At, B1); PG8_BAR; PG8_SCHED;
            } else {
            PG8_LDB(B0, 0, 0); PG8_SCHED; PG8_LDA(At, 0, 0); PG8_STAGE(PG8_SA(1, 1), a1 + hstep, voffA);
            PG8_WAIT_L(8); PG8_BAR; PG8_WAIT_L(0); PG8_MMA(0, 0, At, B0); PG8_BAR; PG8_SCHED;
            PG8_LDB(B1, 0, 1); PG8_STAGE(PG8_SB(0, 0), b2, voffB);
            PG8_BAR; PG8_WAIT_L(0); PG8_MMA(0, 1, At, B1); PG8_BAR;
            PG8_LDA(At, 0, 1); PG8_STAGE(PG8_SA(0, 0), a2, voffA);
            PG8_BAR; PG8_WAIT_L(0); PG8_MMA(1, 0, At, B0); PG8_BAR; PG8_SCHED;
            PG8_STAGE(PG8_SB(0, 1), b2 + hstep, voffB);
            PG8_WAIT_V(6); PG8_BAR; PG8_MMA(1, 1, At, B1); PG8_BAR;
            PG8_LDB(B0, 1, 0); PG8_SCHED; PG8_LDA(At, 1, 0); PG8_STAGE(PG8_SA(0, 1), a2 + hstep, voffA);
            PG8_WAIT_L(8); PG8_BAR; PG8_WAIT_L(0); PG8_MMA(0, 0, At, B0); PG8_BAR; PG8_SCHED;
            PG8_LDB(B1, 1, 1); PG8_STAGE(PG8_SB(1, 0), b3, voffB);
            PG8_BAR; PG8_WAIT_L(0); PG8_MMA(0, 1, At, B1); PG8_BAR;
            PG8_LDA(At, 1, 1); PG8_STAGE(PG8_SA(1, 0), a3, voffA);
            PG8_BAR; PG8_WAIT_L(0); PG8_MMA(1, 0, At, B0); PG8_BAR; PG8_SCHED;
            PG8_STAGE(PG8_SB(1, 1), b3 + hstep, voffB);
            PG8_WAIT_V(6); PG8_BAR; PG8_MMA(1, 1, At, B1); PG8_BAR;
            }
        }
        if constexpr (ALIGN_EPI) { if (wr == 0) PG8_BAR; }
        if constexpr (!Epi::AFTER_DRAIN) { E(acc, cur, wr, wc, fr, fq); S.done(cur); }
        if (!has_next) break;
#pragma unroll
        for (int a = 0; a < 2; ++a)
#pragma unroll
            for (int b = 0; b < 2; ++b)
#pragma unroll
                for (int m = 0; m < 4; ++m)
#pragma unroll
                    for (int n = 0; n < 2; ++n) acc[a][b][m][n] = (f32x4){0.f, 0.f, 0.f, 0.f};
        cur = nxt; cA = nA; cB = nB; ++ui;
        if constexpr (ALIGN_EPI) { if (wr == 1) PG8_BAR; }
    }
    PG8_WAIT_V(0);
    if constexpr (!ALIGN_EPI) { if (wr == 0) PG8_BAR; }
    PG8_BAR;
    if constexpr (Epi::AFTER_DRAIN) { E.fused(acc, cur, wr, wc, fr, fq, lds, wid, lane); S.done(cur); }
#undef PG8_SA
#undef PG8_SB
#undef PG8_STAGE
#undef PG8_LDA
#undef PG8_LDB
#undef PG8_MMA
#undef PG8_WAIT_V
#undef PG8_WAIT_L
#undef PG8_BAR
#undef PG8_SCHED
}
}

#ifndef MK_ONE_LAUNCH
#define MK_ONE_LAUNCH 1
#endif
constexpr int NWAVES = 8, NTHR = 512;
constexpr int BATCH = 4, SEQ = 2048, DM = 2048, T = BATCH * SEQ;
constexpr int AW = 1024, RW = 1024, NIN = 5120, NH = 8, HD = 128;
constexpr int PH = 8, NK = 128, TOPK = 16, NE = 128;
constexpr float ALPHA = 1.18920711500272f, LN_EPS = 1e-5f;
constexpr int NPH = 11;
constexpr size_t MiB = 1u << 20;
constexpr size_t WS_CTL = 0, CTL_ZERO_BYTES = 128 * 1024;
constexpr int CW_BAR = 4096;
constexpr int CW_SEAM = 16384;
constexpr size_t WS_XCH = 1 * MiB;
constexpr size_t WS_ROPE = 2 * MiB;
constexpr size_t WS_WGT = 6 * MiB;
constexpr size_t WS_SU = 6 * MiB + 512 * 1024;
constexpr size_t WS_CHA = 7 * MiB, WS_CHH = 7 * MiB + 512 * 1024;
constexpr size_t WS_KEYB = 7 * MiB + 768 * 1024;
constexpr size_t WS_WOUT = 8 * MiB, WS_WQ = 16 * MiB, WS_WIN = 24 * MiB;
constexpr size_t WS_XB = 48 * MiB;
constexpr size_t WS_OP = 80 * MiB, WS_LSE = 128 * MiB;
constexpr size_t WS_H1B = 208 * MiB;
constexpr size_t WS_Q = 240 * MiB, WS_K = 256 * MiB, WS_V = 272 * MiB, WS_XR = 288 * MiB, WS_GGB = 304 * MiB;
constexpr size_t WS_Q2 = 240 * MiB;
constexpr size_t WS_IDX = 304 * MiB, WS_GATE = 308 * MiB;
constexpr size_t WS_UT8 = 320 * MiB, WS_VT8 = 352 * MiB;
constexpr size_t WS_REC1 = 384 * MiB, WS_PG = 416 * MiB;
constexpr size_t WS_H1Q = 384 * MiB;
constexpr size_t WS_MIX = 480 * MiB;
constexpr size_t WS_END = 512 * MiB;
constexpr int RING_OFF = 0, RING_BYTES = 131072;
constexpr int LDSCTL_OFF = RING_BYTES, MISC_OFF = LDSCTL_OFF + 320, PTRTAB_OFF = LDSCTL_OFF + 1024;
constexpr int LDS_BYTES = 147456;

#define GAS __attribute__((address_space(1)))
#define LAS __attribute__((address_space(3)))
typedef unsigned short bf16;
typedef unsigned v4u __attribute__((ext_vector_type(4)));
typedef unsigned v2u __attribute__((ext_vector_type(2)));
typedef float f32x4 __attribute__((ext_vector_type(4)));
typedef GAS unsigned gu32;
#define RLX_AGENT __ATOMIC_RELAXED, __HIP_MEMORY_SCOPE_AGENT
#define LDS_WAIT() asm volatile("s_waitcnt lgkmcnt(0)" ::: "memory")
#define VM_WAIT() asm volatile("s_waitcnt vmcnt(0)" ::: "memory")
__device__ __forceinline__ unsigned f2bf(float f) { unsigned u = __builtin_bit_cast(unsigned, f); return (u + 0x7fffu + ((u >> 16) & 1u)) >> 16; }
__device__ __forceinline__ unsigned pk2(float lo, float hi) { return f2bf(lo) | (f2bf(hi) << 16); }
__device__ __forceinline__ float bf2f(unsigned short b) { return __builtin_bit_cast(float, ((unsigned)b) << 16); }
__device__ __forceinline__ float u2f(unsigned u) { return __builtin_bit_cast(float, u); }
__device__ __forceinline__ unsigned f2u(float f) { return __builtin_bit_cast(unsigned, f); }
__device__ __forceinline__ float bflo(unsigned w) { return __builtin_bit_cast(float, w << 16); }
__device__ __forceinline__ float bfhi(unsigned w) { return __builtin_bit_cast(float, w & 0xffff0000u); }
__device__ __forceinline__ float xor32(float x) {
    const v2u r = __builtin_bit_cast(v2u, __builtin_amdgcn_permlane32_swap(__builtin_bit_cast(unsigned, x), __builtin_bit_cast(unsigned, x), false, false));
    return __builtin_bit_cast(float, (threadIdx.x & 32) ? r.x : r.y);
}
__device__ __forceinline__ float xor16(float x) {
    const v2u r = __builtin_bit_cast(v2u, __builtin_amdgcn_permlane16_swap(__builtin_bit_cast(unsigned, x), __builtin_bit_cast(unsigned, x), false, false));
    return __builtin_bit_cast(float, (threadIdx.x & 16) ? r.x : r.y);
}
__device__ __forceinline__ float wave_sum(float v) {
    v += __builtin_bit_cast(float, __builtin_amdgcn_update_dpp(0, __builtin_bit_cast(int, v), 0xB1, 0xf, 0xf, true));
    v += __builtin_bit_cast(float, __builtin_amdgcn_update_dpp(0, __builtin_bit_cast(int, v), 0x4E, 0xf, 0xf, true));
    v += __shfl_xor(v, 4); v += __shfl_xor(v, 8);
    v += xor16(v); v += xor32(v);
    return v;
}
__device__ __forceinline__ float wave_max(float v) {
#pragma unroll
    for (int o = 1; o < 64; o <<= 1) v = fmaxf(v, __shfl_xor(v, o));
    return v;
}
__device__ __forceinline__ float gelu_tanh(float x) { const float u = 0.7978845608028654f * (x + 0.044715f * x * x * x); return x / (1.0f + __expf(-2.0f * u)); }
__device__ __forceinline__ float sigmoidf_(float x) { return 1.0f / (1.0f + __expf(-x)); }

#define XB_TMO      128
#define XB_XCNT(j)  (256  + 64 * (j))
#define XB_XSUB(j)  (1280 + 64 * (j))
#define XB_XGEN(j)  (2304 + 64 * (j))
#define XB_TOP      3328
#define XB_TOPGEN   3392
#define XCD_BAR_WORDS 3456
#define XB_SPIN_CAP (1u << 18)

__device__ __forceinline__ unsigned xb_ld(unsigned* p)              { return __hip_atomic_load(p, __ATOMIC_RELAXED, __HIP_MEMORY_SCOPE_AGENT); }
__device__ __forceinline__ unsigned xb_add(unsigned* p, unsigned v) { return __hip_atomic_fetch_add(p, v, __ATOMIC_RELAXED, __HIP_MEMORY_SCOPE_AGENT); }
__device__ __forceinline__ unsigned xb_xcc_id() { return (unsigned)__builtin_amdgcn_s_getreg((3 << 11) | 20) & 0xFu; }
#define XB_SPIN(cond, bar) do { unsigned _sp = 0; while (cond) { __builtin_amdgcn_s_sleep(1); \
    if ((++_sp & 255u) == 0u) { if (xb_ld(&(bar)[XB_TMO])) break; if (_sp > XB_SPIN_CAP) { atomicAdd(&(bar)[XB_TMO], 1u); break; } } } } while (0)

struct XcdBarrier {
    unsigned* bar; unsigned x;
    volatile LAS unsigned* st;
};

__device__ __forceinline__ XcdBarrier xcd_barrier_post(unsigned* bar, volatile LAS unsigned* st) {
    XcdBarrier b; b.bar = bar; b.x = xb_xcc_id(); b.st = st;
    if (threadIdx.x == 0) (void)xb_add(&bar[XB_XCNT(b.x)], 1u);
    return b;
}
__device__ __forceinline__ void xcd_barrier_complete(unsigned* bar, unsigned x, unsigned& nloc, unsigned& nx) {
    const unsigned G = gridDim.x * gridDim.y * gridDim.z;
    unsigned sum, cnt, mine, sp = 0u;
    for (;;) {
        sum = 0u; cnt = 0u; mine = 0u;
#pragma unroll
        for (unsigned j = 0; j < 16; ++j) { const unsigned c = xb_ld(&bar[XB_XCNT(j)]); sum += c; cnt += (c > 0u) ? 1u : 0u; mine = (j == x) ? c : mine; }
        if (sum == G) break;
        __builtin_amdgcn_s_sleep(1);
        if ((++sp & 255u) == 0u) { if (xb_ld(&bar[XB_TMO])) break; if (sp > XB_SPIN_CAP) { atomicAdd(&bar[XB_TMO], 1u); break; } }
    }
    nloc = mine > 0u ? mine : 1u; nx = cnt > 0u ? cnt : 1u;
}

__device__ __forceinline__ void xcd_barrier(const XcdBarrier& b) {
    asm volatile("s_waitcnt vmcnt(0)" ::: "memory");
    __syncthreads();
    if (threadIdx.x == 0) {
        unsigned* bar = b.bar;
        __builtin_amdgcn_s_waitcnt(0);
        unsigned nloc = b.st[0], nx = b.st[1];
        if (nloc == 0u) { xcd_barrier_complete(bar, b.x, nloc, nx); b.st[0] = nloc; b.st[1] = nx; }
        const unsigned old = xb_add(&bar[XB_XSUB(b.x)], 1u);
        const unsigned gen = old / nloc;
        if (old + 1u == (gen + 1u) * nloc) {
            __builtin_amdgcn_fence(__ATOMIC_RELEASE, "agent");
            asm volatile("s_waitcnt vmcnt(0)" ::: "memory");
            const unsigned og = xb_add(&bar[XB_TOP], 1u);
            const unsigned tg = og / nx;
            if (og + 1u == (tg + 1u) * nx) xb_add(&bar[XB_TOPGEN], 1u);
            else XB_SPIN(xb_ld(&bar[XB_TOPGEN]) == tg, bar);
            __builtin_amdgcn_fence(__ATOMIC_ACQUIRE, "agent");
            xb_add(&bar[XB_XGEN(b.x)], 1u);
            asm volatile("s_waitcnt vmcnt(0)" ::: "memory");
        } else {
            XB_SPIN(xb_ld(&bar[XB_XGEN(b.x)]) == gen, bar);
            __builtin_amdgcn_fence(__ATOMIC_ACQUIRE, "agent");
            asm volatile("s_waitcnt vmcnt(0)" ::: "memory");
        }
    }
    __syncthreads();
}


enum PtrIdx { PX = 0, PPOS, PW_IN, PCONV_W, PCONV_B, PW_A, PB_A, PW_X, PB_X, PLAM, PGN_ATTN, PGN_REC, PW_OUT, PLN1_G, PLN1_B, PWQ, PKEYS1, PKEYS2, PPU, PPV, PLN2_G, PLN2_B, POUT, PN };
struct Frame {
    LAS unsigned char* lds;
    volatile LAS unsigned* MISC;
    gu32* ctl;
    int tid, lane, wave;
    int vcu, G;
    unsigned char* ws;
    template <class Tp> __device__ __forceinline__ Tp* ptr(int k) const {
        volatile LAS unsigned* t = (volatile LAS unsigned*)(lds + PTRTAB_OFF) + 2 * k;
        const unsigned lo = (unsigned)__builtin_amdgcn_readfirstlane((int)t[0]), hi = (unsigned)__builtin_amdgcn_readfirstlane((int)t[1]);
        return (Tp*)(((unsigned long long)hi << 32) | lo);
    }
};

template <bool ROPEPERM> __device__ __forceinline__ void p0_transpose_item(const float* W, int K, int N, bf16* WT, LAS float* scr, int item, int lane) {
    const int nblk = N / 32, kb = item / nblk, nb = item % nblk, k0 = 64 * kb, n0 = 32 * nb;
    {
        f32x4 t[8];
#pragma unroll
        for (int i = 0; i < 8; ++i) t[i] = *(const f32x4*)(W + (size_t)(k0 + 8 * i + (lane >> 3)) * N + n0 + 4 * (lane & 7));
#pragma unroll
        for (int i = 0; i < 8; ++i) { LAS float* d = scr + (8 * i + (lane >> 3)) * 33 + 4 * (lane & 7); d[0] = t[i].x; d[1] = t[i].y; d[2] = t[i].z; d[3] = t[i].w; }
    }
    LDS_WAIT(); asm volatile("" ::: "memory");
    const int c = lane & 7;
#pragma unroll
    for (int j = 0; j < 4; ++j) { const int n = (lane >> 3) + 8 * j; const LAS float* s = scr + (8 * c) * 33 + n;
        v4u o; o.x = pk2(s[0 * 33], s[1 * 33]); o.y = pk2(s[2 * 33], s[3 * 33]); o.z = pk2(s[4 * 33], s[5 * 33]); o.w = pk2(s[6 * 33], s[7 * 33]);
        int nr = n0 + n; if (ROPEPERM && nr < 2048) { const int d = nr & 127; nr = (nr & ~127) + 8 * ((d & 63) >> 2) + 4 * (d >> 6) + (d & 3); }
        *(v4u*)(WT + (size_t)nr * K + k0 + 8 * c) = o; }
    LDS_WAIT(); asm volatile("" ::: "memory");
}

__device__ __forceinline__ void p0_prep(Frame& F) {
    const float* const p_w_in = F.ptr<const float>(PW_IN);
    const float* const p_w_out = F.ptr<const float>(PW_OUT);
    const float* const p_wq = F.ptr<const float>(PWQ);
    const float* const p_x = F.ptr<const float>(PX);
    const float* const p_w_x = F.ptr<const float>(PW_X);
    const float* const p_w_a = F.ptr<const float>(PW_A);
    const int* const p_pos = F.ptr<const int>(PPOS);

    LAS float* scr = (LAS float*)(F.lds + RING_OFF + F.wave * 16384);
    const int gw = F.vcu * NWAVES + F.wave, NGW = F.G * NWAVES;
    constexpr int I_IN = (DM / 64) * (NIN / 32), I_O = (DM / 64) * (DM / 32), I_Q = I_O;
    bf16* Win_t = (bf16*)(F.ws + WS_WIN); bf16* Wout_t = (bf16*)(F.ws + WS_WOUT); bf16* Wq_t = (bf16*)(F.ws + WS_WQ);
    const int n_items = (F.G == 256) ? I_IN : I_IN + I_O + I_Q;
    for (int it = gw; it < n_items; it += NGW) {
        int r = it;
        if (r < I_IN) { p0_transpose_item<true>(p_w_in, DM, NIN, Win_t, scr, r, F.lane); continue; } r -= I_IN;
        if (r < I_O) { p0_transpose_item<false>(p_w_out, DM, DM, Wout_t, scr, r, F.lane); continue; } r -= I_O;
        p0_transpose_item<false>(p_wq, DM, DM, Wq_t, scr, r, F.lane);
    }
    const size_t gt = (size_t)blockIdx.x * NTHR + F.tid, GT = (size_t)F.G * NTHR;
    {
        const f32x4* x4 = (const f32x4*)p_x; v2u* xb = (v2u*)(F.ws + WS_XB);
        for (size_t i = gt; i < (size_t)T * DM / 4; i += GT) { const f32x4 v = x4[i]; v2u o; o.x = pk2(v.x, v.y); o.y = pk2(v.z, v.w); xb[i] = o; }
    }
    {
        bf16* wgt = (bf16*)(F.ws + WS_WGT);
        for (size_t i = gt; i < (size_t)8 * 256 * 128; i += GT) { const int c = (int)(i & 127), col = (int)((i >> 7) & 255), n = (int)(i >> 15); const int g = col >> 7, dd = col & 127;
            wgt[i] = (bf16)f2bf((g ? p_w_x : p_w_a)[((size_t)n * 128 + c) * 128 + dd]); }
    }
    {
        const float* const p_k1 = F.ptr<const float>(PKEYS1); const float* const p_k2 = F.ptr<const float>(PKEYS2); bf16* kb = (bf16*)(F.ws + WS_KEYB);
        for (size_t i = gt; i < (size_t)2 * 128 * 128; i += GT) { const int tbl = (int)(i >> 14), e = (int)(i & 16383); const float v = (tbl ? p_k2 : p_k1)[e];
            const unsigned hi = f2bf(v); const float lo = v - bf2f((unsigned short)hi); kb[(size_t)tbl * 32768 + e] = (bf16)hi; kb[(size_t)tbl * 32768 + 16384 + e] = (bf16)f2bf(lo); }
    }
    {
        float* ct = (float*)(F.ws + WS_ROPE); float* st = ct + (size_t)T * 64;
        for (size_t i = gt; i < (size_t)T * 64; i += GT) {
            const int tok = (int)(i >> 6), k = (int)(i & 63);
            const float inv = expf(-(float)k * (9.210340371976184f / 64.0f));
            const float ang = (float)p_pos[tok] * inv;
            const double rev = (double)ang * 0.15915494309189535;
            const float fr = (float)(rev - floor(rev));
            ct[i] = __builtin_amdgcn_cosf(fr); st[i] = __builtin_amdgcn_sinf(fr);
        }
    }
}
__device__ __forceinline__ void p0_late_transposes(Frame& F, int wg, int nwg) {
    const float* const p_w_out = F.ptr<const float>(PW_OUT);
    const float* const p_wq = F.ptr<const float>(PWQ);
    LAS float* scr = (LAS float*)(F.lds + RING_OFF + F.wave * 16384);
    constexpr int I_O = (DM / 64) * (DM / 32);
    bf16* Wout_t = (bf16*)(F.ws + WS_WOUT); bf16* Wq_t = (bf16*)(F.ws + WS_WQ);
    __syncthreads();
    for (int it = wg * NWAVES + F.wave; it < 2 * I_O; it += nwg * NWAVES) {
        if (it < I_O) p0_transpose_item<false>(p_w_out, DM, DM, Wout_t, scr, it, F.lane); else p0_transpose_item<false>(p_wq, DM, DM, Wq_t, scr, it - I_O, F.lane);
    }
}

namespace att {
using bf16x8 = __attribute__((ext_vector_type(8))) short;
using s16x4 = __attribute__((ext_vector_type(4))) short;
using f32x16 = __attribute__((ext_vector_type(16))) float;
using u32x4 = __attribute__((ext_vector_type(4))) unsigned;
#define ATT_MFMA(a, b, c) __builtin_amdgcn_mfma_f32_32x32x16_bf16((a), (b), (c), 0, 0, 0)
__device__ __forceinline__ bf16x8 pack8(float a0, float a1, float a2, float a3, float a4, float a5, float a6, float a7) {
    u32x4 p;
    asm volatile("s_nop 1\n\tv_cvt_pk_bf16_f32 %0, %4, %5\n\tv_cvt_pk_bf16_f32 %1, %6, %7\n\tv_cvt_pk_bf16_f32 %2, %8, %9\n\tv_cvt_pk_bf16_f32 %3, %10, %11\n\ts_nop 1"
                 : "=&v"(p[0]), "=&v"(p[1]), "=&v"(p[2]), "=&v"(p[3]) : "v"(a0), "v"(a1), "v"(a2), "v"(a3), "v"(a4), "v"(a5), "v"(a6), "v"(a7));
    return __builtin_bit_cast(bf16x8, p);
}
template <int S> __device__ __forceinline__ void vt_read(unsigned base, s16x4 (&lo)[4], s16x4 (&hi)[4]) {
    asm volatile("ds_read_b64_tr_b16 %0, %8 offset:%9\n\tds_read_b64_tr_b16 %1, %8 offset:%10\n\tds_read_b64_tr_b16 %2, %8 offset:%11\n\tds_read_b64_tr_b16 %3, %8 offset:%12\n\t"
                 "ds_read_b64_tr_b16 %4, %8 offset:%13\n\tds_read_b64_tr_b16 %5, %8 offset:%14\n\tds_read_b64_tr_b16 %6, %8 offset:%15\n\tds_read_b64_tr_b16 %7, %8 offset:%16\n\ts_waitcnt lgkmcnt(0)"
                 : "=&v"(lo[0]), "=&v"(lo[1]), "=&v"(lo[2]), "=&v"(lo[3]), "=&v"(hi[0]), "=&v"(hi[1]), "=&v"(hi[2]), "=&v"(hi[3])
                 : "v"(base), "i"((2 * S) * 2048 + 0), "i"((2 * S) * 2048 + 512), "i"((2 * S) * 2048 + 1024), "i"((2 * S) * 2048 + 1536),
                   "i"((2 * S + 1) * 2048 + 0), "i"((2 * S + 1) * 2048 + 512), "i"((2 * S + 1) * 2048 + 1024), "i"((2 * S + 1) * 2048 + 1536) : "memory");
}
#define ATT_DMA(voff_, sbase_, lds_) asm volatile("s_mov_b32 m0, %2\n\ts_nop 0\n\tglobal_load_lds_dwordx4 %0, %1" :: "v"(voff_), "s"(sbase_), "s"(lds_) : "memory", "m0")
template <int PAT>
__device__ __forceinline__ void attn_round(const bf16* Q, const bf16* K, const bf16* V, bf16* OP, float* LSE, LAS unsigned char* lds, int b, int h, int g, int wave, int lane) {
    constexpr int d = (PAT == 0) ? 1 : (PAT == 1 ? 4 : 16);
    asm volatile("" : "+v"(lane));
    const int r = lane & 31, hh = lane >> 5;
    const int hf = wave >> 2, w4 = wave & 3;
    const int hi = 2 * g + hf, hio = 2 * g + (hf ^ 1);
    const int c = (PAT == 0) ? 0 : (PAT == 1 ? (hi >> 2) : hi);
    const int j0 = (PAT == 0) ? 4 * hi : (PAT == 1 ? 4 * (hi & 3) : 0), j0o = (PAT == 0) ? 4 * hio : (PAT == 1 ? 4 * (hio & 3) : 0);
    const int tlo = (j0 >= 4) ? j0 - 4 : 0, nt = j0 + 4 - tlo;
    const int nto = (j0o >= 4) ? 8 : 4;
    const int nsteps = (nt > nto) ? nt : nto;
    const int j = j0 + w4, kt0 = (j >= 4) ? j - 4 : 0;
    const size_t tokq = (size_t)b * SEQ + (size_t)(32 * j + r) * d + c;
    bf16x8 qf[8];
    { const bf16x8* qp = (const bf16x8*)(Q + tokq * AW + h * HD + 8 * hh);
#pragma unroll
      for (int s = 0; s < 8; ++s) qf[s] = qp[2 * s]; }
    f32x16 o[4];
#pragma unroll
    for (int dt = 0; dt < 4; ++dt)
#pragma unroll
        for (int i = 0; i < 16; ++i) o[dt][i] = 0.f;
    float m = -1.0e30f, l = 0.f;
    const unsigned hbase = (unsigned)__builtin_amdgcn_readfirstlane((int)(unsigned)(size_t)lds) + (unsigned)hf * 65536u;
    const unsigned troff = (unsigned)((4 * hh + ((lane & 15) >> 2)) * 64 + (16 * ((lane >> 4) & 1) + 4 * (lane & 3)) * 2);
    const unsigned kfoff = 8192u + (unsigned)r * 256u;
    const char* const Kb = (const char*)(K + ((size_t)b * SEQ + c) * AW + h * HD);
    const char* const Vb = (const char*)(V + ((size_t)b * SEQ + c) * AW + h * HD);
    constexpr unsigned rowb = (unsigned)(d * AW * 2);
    unsigned ko[2], vo[2];
#pragma unroll
    for (int q = 0; q < 2; ++q) { const int i = 2 * w4 + q; const int row = 4 * i + (lane >> 4); ko[q] = (unsigned)row * rowb + (unsigned)(((lane & 15) ^ (row & 15)) * 16);
        const int key = 8 * (i >> 1) + ((lane & 31) >> 2); vo[q] = (unsigned)key * rowb + (unsigned)((4 * (2 * (i & 1) + (lane >> 5)) + (lane & 3)) * 16); }
#define ATT_ISSUE(t_) do { const size_t tb_ = (size_t)(tlo + (t_)) * 32 * rowb; const unsigned sl_ = hbase + (unsigned)((t_) & 3) * 16384u + (unsigned)(2 * w4) * 1024u; \
        ATT_DMA(ko[0], Kb + tb_, sl_ + 8192u); ATT_DMA(ko[1], Kb + tb_, sl_ + 8192u + 1024u); ATT_DMA(vo[0], Vb + tb_, sl_); ATT_DMA(vo[1], Vb + tb_, sl_ + 1024u); } while (0)
    asm volatile("s_waitcnt lgkmcnt(0)\n\ts_barrier" ::: "memory");
    ATT_ISSUE(0); ATT_ISSUE(1); ATT_ISSUE(2);
#pragma unroll
    for (int s = 0; s < 8; ++s) asm volatile("" :: "v"(qf[s]));
#define ATT_QK(dst_, t_) do { const unsigned sb_ = hbase + (unsigned)((t_) & 3) * 16384u; bf16x8 kf[8]; \
        _Pragma("unroll") for (int t = 0; t < 8; ++t) kf[t] = *(const LAS bf16x8*)(size_t)(sb_ + kfoff + (unsigned)(((2 * t + hh) ^ (r & 15)) * 16)); \
        __builtin_amdgcn_sched_barrier(0); \
        _Pragma("unroll") for (int i = 0; i < 16; ++i) dst_[i] = 0.f; \
        _Pragma("unroll") for (int t = 0; t < 8; ++t) dst_ = ATT_MFMA(kf[t], qf[t], dst_); } while (0)
#define ATT_ACTIVE(s_) ((s_) < nt && tlo + (s_) >= kt0 && tlo + (s_) <= j)
    asm volatile("s_waitcnt vmcnt(8)" ::: "memory");
    asm volatile("s_waitcnt lgkmcnt(0)\n\ts_barrier" ::: "memory");
    f32x16 sacc;
#pragma unroll
    for (int i = 0; i < 16; ++i) sacc[i] = 0.f;
    if (ATT_ACTIVE(0)) ATT_QK(sacc, 0);
#pragma unroll 1
    for (int s = 0; s < nsteps; ++s) {
        {   const int last = (s + 2 < nt - 1) ? s + 2 : nt - 1; const int ahead = last - (s + 1);
            if (ahead >= 1) asm volatile("s_waitcnt vmcnt(4)" ::: "memory"); else asm volatile("s_waitcnt vmcnt(0)" ::: "memory"); }
        asm volatile("s_waitcnt lgkmcnt(0)\n\ts_barrier" ::: "memory");
        if (s + 3 < nt) ATT_ISSUE(s + 3);
        f32x16 snext;
#pragma unroll
        for (int i = 0; i < 16; ++i) snext[i] = 0.f;
        if (ATT_ACTIVE(s + 1)) ATT_QK(snext, s + 1);
        const int kt = tlo + s;
        if (ATT_ACTIVE(s)) {
            const unsigned sb = hbase + (unsigned)(s & 3) * 16384u;
            if (kt == j) {
#pragma unroll
                for (int i = 0; i < 16; ++i) { const int kr = (i & 3) + 8 * (i >> 2) + 4 * hh; sacc[i] = (kr <= r) ? sacc[i] : -1.0e30f; }
            }
            if (kt == j - 4) {
#pragma unroll
                for (int i = 0; i < 16; ++i) { const int kr = (i & 3) + 8 * (i >> 2) + 4 * hh; sacc[i] = (kr >= r) ? sacc[i] : -1.0e30f; }
            }
            float mx = sacc[0];
#pragma unroll
            for (int i = 1; i < 16; ++i) mx = fmaxf(mx, sacc[i]);
            mx = fmaxf(mx, xor32(mx));
            const float mn = fmaxf(m, mx);
            const float alpha = __builtin_amdgcn_exp2f(m - mn);
            float ps = 0.f;
#pragma unroll
            for (int i = 0; i < 16; ++i) { sacc[i] = __builtin_amdgcn_exp2f(sacc[i] - mn); ps += sacc[i]; }
            ps += xor32(ps);
            l = l * alpha + ps; m = mn;
#pragma unroll
            for (int dt = 0; dt < 4; ++dt)
#pragma unroll
                for (int i = 0; i < 16; ++i) o[dt][i] *= alpha;
            const unsigned trb = sb + troff;
            {
                const bf16x8 pb = pack8(sacc[0], sacc[1], sacc[2], sacc[3], sacc[4], sacc[5], sacc[6], sacc[7]);
                s16x4 lo[4], hi4[4]; vt_read<0>(trb, lo, hi4);
#pragma unroll
                for (int dt = 0; dt < 4; ++dt) { const bf16x8 va = __builtin_shufflevector(lo[dt], hi4[dt], 0, 1, 2, 3, 4, 5, 6, 7); o[dt] = ATT_MFMA(va, pb, o[dt]); }
            }
            {
                const bf16x8 pb = pack8(sacc[8], sacc[9], sacc[10], sacc[11], sacc[12], sacc[13], sacc[14], sacc[15]);
                s16x4 lo[4], hi4[4]; vt_read<1>(trb, lo, hi4);
#pragma unroll
                for (int dt = 0; dt < 4; ++dt) { const bf16x8 va = __builtin_shufflevector(lo[dt], hi4[dt], 0, 1, 2, 3, 4, 5, 6, 7); o[dt] = ATT_MFMA(va, pb, o[dt]); }
            }
        }
        sacc = snext;
    }
#undef ATT_QK
#undef ATT_ACTIVE
    const float inv = 1.0f / l;
    bf16* op = OP + (size_t)PAT * T * AW + tokq * AW + h * HD + 4 * hh;
#pragma unroll
    for (int dt = 0; dt < 4; ++dt)
#pragma unroll
        for (int gq = 0; gq < 4; ++gq) { v2u w; w.x = pk2(o[dt][4 * gq] * inv, o[dt][4 * gq + 1] * inv); w.y = pk2(o[dt][4 * gq + 2] * inv, o[dt][4 * gq + 3] * inv); *(v2u*)(op + 32 * dt + 8 * gq) = w; }
    if (hh == 0) LSE[(size_t)PAT * T * NH + tokq * NH + h] = m + __builtin_amdgcn_logf(l);
#undef ATT_ISSUE
}
}

__device__ __forceinline__ void p3_attn_mfma(Frame& F) {
    const bf16* Q = (const bf16*)(F.ws + WS_Q); const bf16* K = (const bf16*)(F.ws + WS_K); const bf16* V = (const bf16*)(F.ws + WS_V);
    bf16* OP = (bf16*)(F.ws + WS_OP); float* LSE = (float*)(F.ws + WS_LSE);
    for (int w = F.vcu; w < 256; w += F.G) {
        const int bh = w >> 3, g = w & 7, b = bh >> 3, h = bh & 7;
        att::attn_round<0>(Q, K, V, OP, LSE, F.lds, b, h, g, F.wave, F.lane);
        att::attn_round<1>(Q, K, V, OP, LSE, F.lds, b, h, g, F.wave, F.lane);
        att::attn_round<2>(Q, K, V, OP, LSE, F.lds, b, h, g, F.wave, F.lane);
    }
    asm volatile("s_waitcnt lgkmcnt(0)\n\ts_barrier" ::: "memory");
}


namespace rec {
using bf16x8 = __attribute__((ext_vector_type(8))) short;
using f32x16 = __attribute__((ext_vector_type(16))) float;
constexpr int AROW = 272;
__device__ __forceinline__ void rec_wave_item(Frame& F, int b, int chunk, int n, int wq, LAS unsigned char* hb) {
    const float* const p_conv_b = F.ptr<const float>(PCONV_B);
    const float* const p_conv_w = F.ptr<const float>(PCONV_W);
    const float* const p_b_x = F.ptr<const float>(PB_X);
    const float* const p_b_a = F.ptr<const float>(PB_A);
    const float* const p_lam = F.ptr<const float>(PLAM);
    const bf16* XR = (const bf16*)(F.ws + WS_XR); const bf16* GGB = (const bf16*)(F.ws + WS_GGB);
    const bf16* WGT = (const bf16*)(F.ws + WS_WGT);
    bf16* REC1 = (bf16*)(F.ws + WS_REC1); bf16* PG = (bf16*)(F.ws + WS_PG);
    float* CHA = (float*)(F.ws + WS_CHA); float* CHH = (float*)(F.ws + WS_CHH);
    const int lane = F.lane, r = lane & 31, hh = lane >> 5;
    const size_t tok0 = (size_t)b * SEQ + (size_t)chunk * 128;
    LAS unsigned char* const ggt = hb + 17408 + wq * 6144;
    LAS unsigned char* const r1t = ggt + 2048;
    LAS unsigned char* const pgt = ggt + 4096;
    const int pc = lane & 15, rq = lane >> 4; const int cb = n * 128 + 8 * pc;
    f32x4 cw0[4], cw1[4];
#pragma unroll
    for (int j = 0; j < 4; ++j) { cw0[j] = *(const f32x4*)(p_conv_w + j * RW + cb); cw1[j] = *(const f32x4*)(p_conv_w + j * RW + cb + 4); }
    const f32x4 cbi0 = *(const f32x4*)(p_conv_b + cb), cbi1 = *(const f32x4*)(p_conv_b + cb + 4);
    bf16x8 bfa[8], bfx[8];
    { const bf16x8* wa = (const bf16x8*)(WGT + ((size_t)n * 256 + 32 * wq + r) * 128 + 8 * hh); const bf16x8* wx = (const bf16x8*)(WGT + ((size_t)n * 256 + 128 + 32 * wq + r) * 128 + 8 * hh);
#pragma unroll
      for (int s = 0; s < 8; ++s) { bfa[s] = wa[2 * s]; bfx[s] = wx[2 * s]; } }
    const int chl = 32 * wq + r, ch = n * 128 + chl;
    const float bias_a = p_b_a[ch], bias_x = p_b_x[ch];
    const float sp8 = -8.0f * log1pf(expf(-p_lam[ch]));
    float h = 0.f, P = 1.f;
    v4u xw[2][4], gq[2];
#define REC_ISSUE(rt_) do { _Pragma("unroll") for (int i = 0; i < 2; ++i) { const int t_ = 32 * (rt_) + 8 * wq + rq + 4 * i; \
            _Pragma("unroll") for (int j = 0; j < 4; ++j) { const int tt_ = t_ - (3 - j); const size_t tk_ = (chunk * 128 + tt_ >= 0) ? tok0 + tt_ : tok0;     \
                xw[i][j] = *(const v4u*)(XR + tk_ * RW + cb); } } \
        _Pragma("unroll") for (int k = 0; k < 2; ++k) { const int idx = lane + 64 * k, row = idx >> 2, p4 = idx & 3; gq[k] = *(const v4u*)(GGB + (tok0 + 32 * (rt_) + row) * RW + n * 128 + 32 * wq + 8 * p4); } } while (0)
    REC_ISSUE(0);
#pragma unroll 1
    for (int rt = 0; rt < 4; ++rt) {
        LAS unsigned char* const img = hb + (rt & 1) * 8704;
#pragma unroll
        for (int i = 0; i < 2; ++i) { const int row = 8 * wq + rq + 4 * i, t = 32 * rt + row, s = chunk * 128 + t;
            f32x4 a0 = cbi0, a1 = cbi1;
#pragma unroll
            for (int j = 0; j < 4; ++j) { const int ds = 3 - j; const bool ok = (s - ds >= 0);
                v4u w_ = xw[i][j]; w_.x = ok ? w_.x : 0u; w_.y = ok ? w_.y : 0u; w_.z = ok ? w_.z : 0u; w_.w = ok ? w_.w : 0u;
                a0.x += cw0[j].x * bflo(w_.x); a0.y += cw0[j].y * bfhi(w_.x); a0.z += cw0[j].z * bflo(w_.y); a0.w += cw0[j].w * bfhi(w_.y);
                a1.x += cw1[j].x * bflo(w_.z); a1.y += cw1[j].y * bfhi(w_.z); a1.z += cw1[j].z * bflo(w_.w); a1.w += cw1[j].w * bfhi(w_.w); }
            v4u o; o.x = pk2(a0.x, a0.y); o.y = pk2(a0.z, a0.w); o.z = pk2(a1.x, a1.y); o.w = pk2(a1.z, a1.w);
            *(LAS v4u*)(img + row * AROW + pc * 16) = o; }
#pragma unroll
        for (int k = 0; k < 2; ++k) { const int idx = lane + 64 * k, row = idx >> 2, p4 = idx & 3; *(LAS v4u*)(ggt + row * 64 + p4 * 16) = gq[k]; }
        __builtin_amdgcn_sched_barrier(0);
        { const int rtn = (rt < 3) ? rt + 1 : 3; REC_ISSUE(rtn); }
        __builtin_amdgcn_sched_barrier(0);
        asm volatile("s_waitcnt lgkmcnt(0)\n\ts_barrier" ::: "memory");
        f32x16 acca, accx;
#pragma unroll
        for (int i = 0; i < 16; ++i) { acca[i] = 0.f; accx[i] = 0.f; }
#pragma unroll
        for (int s = 0; s < 8; ++s) { const bf16x8 af = *(const LAS bf16x8*)(img + r * AROW + (16 * s + 8 * hh) * 2);
            acca = __builtin_amdgcn_mfma_f32_32x32x16_bf16(af, bfa[s], acca, 0, 0, 0); accx = __builtin_amdgcn_mfma_f32_32x32x16_bf16(af, bfx[s], accx, 0, 0, 0); }
        float av[16], bv[16];
#pragma unroll
        for (int i = 0; i < 16; ++i) {
            const int tl = (i & 3) + 8 * (i >> 2) + 4 * hh;
            const float rg = sigmoidf_(acca[i] + bias_a), ig = sigmoidf_(accx[i] + bias_x);
            const float xcv = bf2f(*(const LAS unsigned short*)(img + tl * AROW + chl * 2));
            const float a = __expf(rg * sp8);
            av[i] = a; bv[i] = sqrtf(fmaxf(1.0f - a * a, 0.f)) * (ig * xcv);
        }
        float Ar[4], Br[4], hin[4], pin[4];
#pragma unroll
        for (int q = 0; q < 4; ++q) { float A = av[4 * q], B = bv[4 * q];
#pragma unroll
            for (int e = 1; e < 4; ++e) { B = B * av[4 * q + e] + bv[4 * q + e]; A = A * av[4 * q + e]; }
            Ar[q] = A; Br[q] = B; }
#pragma unroll
        for (int k = 0; k < 8; ++k) { const int q = k >> 1; const bool own = (hh == (k & 1));
            if (own) { hin[q] = h; pin[q] = P; }
            const float ho = Ar[q] * h + Br[q], po = P * Ar[q];
            const float hx = xor32(ho), px = xor32(po);
            h = own ? ho : hx; P = own ? po : px; }
#pragma unroll
        for (int q = 0; q < 4; ++q) { float hl = hin[q], pl_ = pin[q];
#pragma unroll
            for (int e = 0; e < 4; ++e) { hl = av[4 * q + e] * hl + bv[4 * q + e]; pl_ = pl_ * av[4 * q + e];
                const int tl = 4 * (2 * q + hh) + e; const float g = bf2f(*(const LAS unsigned short*)(ggt + tl * 64 + r * 2));
                *(LAS unsigned short*)(r1t + tl * 64 + r * 2) = (unsigned short)f2bf(hl * g); *(LAS unsigned short*)(pgt + tl * 64 + r * 2) = (unsigned short)f2bf(pl_ * g); } }
        LDS_WAIT(); asm volatile("" ::: "memory");
#pragma unroll
        for (int k = 0; k < 2; ++k) { const int idx = lane + 64 * k, row = idx >> 2, p4 = idx & 3; const size_t o = (tok0 + 32 * rt + row) * RW + n * 128 + 32 * wq + 8 * p4;
            *(v4u*)(REC1 + o) = *(const LAS v4u*)(r1t + row * 64 + p4 * 16); *(v4u*)(PG + o) = *(const LAS v4u*)(pgt + row * 64 + p4 * 16); }
        LDS_WAIT(); asm volatile("" ::: "memory");
    }
#undef REC_ISSUE
    if (hh == 1) { CHA[((size_t)b * 16 + chunk) * RW + ch] = P; CHH[((size_t)b * 16 + chunk) * RW + ch] = h; }
}
}

__device__ __forceinline__ void p9_convert_tables_q(Frame& F, int row_lo, int row_hi, int wg, int nwg);
__device__ __forceinline__ void p3_rec_local(Frame& F) {
    LAS unsigned char* hb = F.lds + (F.wave >> 2) * 49152;
    const int NW = F.G * NWAVES;
    for (int id = F.vcu * NWAVES + F.wave; id < BATCH * 16 * 8 * 4; id += NW) {
        asm volatile("s_waitcnt lgkmcnt(0)\n\ts_barrier" ::: "memory");
        rec::rec_wave_item(F, id >> 9, (id >> 5) & 15, (id >> 2) & 7, id & 3, hb); }
    asm volatile("s_waitcnt lgkmcnt(0)\n\ts_barrier" ::: "memory");
}

__device__ __forceinline__ void p5_mix(Frame& F) {
    const float* const p_gn_rec = F.ptr<const float>(PGN_REC);
    const float* const p_gn_attn = F.ptr<const float>(PGN_ATTN);

    const bf16* OP = (const bf16*)(F.ws + WS_OP); const float* LSE = (const float*)(F.ws + WS_LSE); const bf16* REC1 = (const bf16*)(F.ws + WS_REC1); const bf16* PG = (const bf16*)(F.ws + WS_PG); bf16* MIX = (bf16*)(F.ws + WS_MIX);
    const float* CHA = (const float*)(F.ws + WS_CHA); const float* CHH = (const float*)(F.ws + WS_CHH);
    const int lane = F.lane;
    LAS float* carry = (LAS float*)F.lds;
    for (int tile = blockIdx.x; tile < T / 32; tile += F.G) {
      { const int b = tile >> 6, chunk = (tile >> 2) & 15;
        for (int ch = F.tid; ch < RW; ch += NTHR) { float c = 0.f; for (int m = 0; m < chunk; ++m) c = CHA[((size_t)b * 16 + m) * RW + ch] * c + CHH[((size_t)b * 16 + m) * RW + ch]; carry[ch] = c; } }
      __syncthreads();
      for (int tk = 0; tk < 4; ++tk) { const int tok = tile * 32 + F.wave * 4 + tk;
#pragma unroll
        for (int half = 0; half < 2; ++half) {
            f32x4 v[4]; float ss = 0.f;
            if (half == 0) {
#pragma unroll
                for (int j = 0; j < 4; ++j) {
                    const int hd = 2 * j + (lane >> 5);
                    const float l0 = LSE[(size_t)tok * NH + hd], l1 = LSE[(size_t)T * NH + (size_t)tok * NH + hd], l2 = LSE[(size_t)2 * T * NH + (size_t)tok * NH + hd];
                    const float mx = fmaxf(l0, fmaxf(l1, l2));
                    float w0 = __builtin_amdgcn_exp2f(l0 - mx), w1 = __builtin_amdgcn_exp2f(l1 - mx), w2 = __builtin_amdgcn_exp2f(l2 - mx);
                    const float wi = 1.0f / (w0 + w1 + w2); w0 *= wi; w1 *= wi; w2 *= wi;
                    const size_t off = (size_t)tok * AW + 4 * lane + 256 * j;
                    const v2u a = *(const v2u*)(OP + off), bb = *(const v2u*)(OP + (size_t)T * AW + off), cc = *(const v2u*)(OP + (size_t)2 * T * AW + off);
                    v[j].x = w0 * bflo(a.x) + w1 * bflo(bb.x) + w2 * bflo(cc.x); v[j].y = w0 * bfhi(a.x) + w1 * bfhi(bb.x) + w2 * bfhi(cc.x);
                    v[j].z = w0 * bflo(a.y) + w1 * bflo(bb.y) + w2 * bflo(cc.y); v[j].w = w0 * bfhi(a.y) + w1 * bfhi(bb.y) + w2 * bfhi(cc.y);
                }
            } else {
#pragma unroll
                for (int j = 0; j < 4; ++j) { const size_t off = (size_t)tok * RW + 4 * lane + 256 * j; const v2u a = *(const v2u*)(REC1 + off), pg = *(const v2u*)(PG + off);
                    const f32x4 cy = *(const LAS f32x4*)(carry + 4 * lane + 256 * j);
                    v[j].x = bflo(a.x) + bflo(pg.x) * cy.x; v[j].y = bfhi(a.x) + bfhi(pg.x) * cy.y; v[j].z = bflo(a.y) + bflo(pg.y) * cy.z; v[j].w = bfhi(a.y) + bfhi(pg.y) * cy.w; }
            }
#pragma unroll
            for (int j = 0; j < 4; ++j) ss += (v[j].x * v[j].x + v[j].y * v[j].y) + (v[j].z * v[j].z + v[j].w * v[j].w);
            const f32x4* g4 = (const f32x4*)(half ? p_gn_rec : p_gn_attn) + lane;
            const float rs = 1.0f / sqrtf(wave_sum(ss) * (1.0f / 1024.0f) + LN_EPS);
            v2u* o = (v2u*)(MIX + (size_t)tok * DM + half * 1024) + lane;
#pragma unroll
            for (int j = 0; j < 4; ++j) { const f32x4 g = g4[64 * j]; v2u w; w.x = pk2(v[j].x * rs * g.x, v[j].y * rs * g.y); w.y = pk2(v[j].z * rs * g.z, v[j].w * rs * g.w); o[64 * j] = w; }
        }
      }
      __syncthreads();
    }
}

namespace tk {
using f32x16 = __attribute__((ext_vector_type(16))) float;
#define TK_CE(a, b) { const float hi_ = __builtin_fmaxf(a, b), lo_ = __builtin_fminf(a, b); a = hi_; b = lo_; }
__device__ __forceinline__ void insert16(float (&l)[16], float x) {
#pragma unroll
    for (int s = 0; s < 16; ++s) { const float hi = __builtin_fmaxf(l[s], x); x = __builtin_fminf(l[s], x); l[s] = hi; }
}
__device__ __forceinline__ void bmerge16(float (&v)[16]) {
#pragma unroll
    for (int j = 8; j >= 1; j >>= 1)
#pragma unroll
        for (int i = 0; i < 16; ++i) { const int l = i ^ j; if (l > i) TK_CE(v[i], v[l]); }
}
__device__ __forceinline__ void bsort16(float (&v)[16]) {
#pragma unroll
    for (int k = 2; k <= 16; k <<= 1)
#pragma unroll
        for (int j = k >> 1; j >= 1; j >>= 1)
#pragma unroll
            for (int i = 0; i < 16; ++i) { const int l = i ^ j; if (l > i) { if ((i & k) == 0 || k == 16) { TK_CE(v[i], v[l]); } else { TK_CE(v[l], v[i]); } } }
}
__device__ __forceinline__ float packlow(float v, unsigned idx, unsigned mask) { return u2f((f2u(v) & ~mask) | idx); }
__device__ __forceinline__ void topk_item(Frame& F, int tile, int h) {
    const float* const p_keys2 = F.ptr<const float>(PKEYS2);
    const float* const p_keys1 = F.ptr<const float>(PKEYS1);

    const bf16* Q2 = (const bf16*)(F.ws + WS_Q2); const float* SU = (const float*)(F.ws + WS_SU);
    const bf16* KB = (const bf16*)(F.ws + WS_KEYB);
    typedef __attribute__((ext_vector_type(8))) short bf16x8_;
    const int lane = F.lane, x = lane & 31, kk = lane >> 5;
    const int tok = tile * 32 + x;
    float lst[2][16];
#pragma unroll
    for (int half = 0; half < 2; ++half) {
        if (half) __syncthreads();
#pragma unroll
        for (int i = 0; i < 8; ++i) { const int L = F.tid + 512 * i, row = L >> 4, pc = L & 15;
            *(LAS v4u*)(F.lds + 65536 + row * 256 + ((pc ^ (row & 15)) << 4)) = *(const v4u*)(KB + (size_t)half * 32768 + (size_t)row * 128 + pc * 8); }
        __syncthreads();
        bf16x8_ qf[8];
        { const bf16x8_* qp = (const bf16x8_*)(Q2 + (size_t)tok * DM + h * 256 + half * 128 + 8 * kk);
#pragma unroll
          for (int s = 0; s < 8; ++s) qf[s] = qp[2 * s]; }
        float l16[16];
#pragma unroll
        for (int rt = 0; rt < 4; ++rt) {
            f32x16 acc;
#pragma unroll
            for (int i = 0; i < 16; ++i) acc[i] = 0.f;
            const LAS unsigned char* krow = F.lds + 65536 + (32 * rt + x) * 256; const int rsw = (32 * rt + x) & 15;
            bf16x8_ ah[8], al[8];
#pragma unroll
            for (int s = 0; s < 8; ++s) { const int po = ((2 * s + kk) ^ rsw) << 4; ah[s] = *(const LAS bf16x8_*)(krow + po); al[s] = *(const LAS bf16x8_*)(krow + 32768 + po); }
#pragma unroll
            for (int s = 0; s < 8; ++s) { acc = __builtin_amdgcn_mfma_f32_32x32x16_bf16(al[s], qf[s], acc, 0, 0, 0); }
#pragma unroll
            for (int s = 0; s < 8; ++s) { acc = __builtin_amdgcn_mfma_f32_32x32x16_bf16(ah[s], qf[s], acc, 0, 0, 0); }
            float nw[16];
#pragma unroll
            for (int i = 0; i < 16; ++i) { const unsigned key = (unsigned)(32 * rt + (i & 3) + 8 * (i >> 2) + 4 * kk); nw[i] = packlow(acc[i], key, 127u); }
            bsort16(nw);
            if (rt == 0) {
#pragma unroll
                for (int s = 0; s < 16; ++s) l16[s] = nw[s];
            } else {
#pragma unroll
                for (int s = 0; s < 16; ++s) l16[s] = __builtin_fmaxf(l16[s], nw[15 - s]);
                bmerge16(l16);
            }
        }
        float mg[16];
#pragma unroll
        for (int s = 0; s < 16; ++s) mg[s] = __builtin_fmaxf(l16[s], xor32(l16[15 - s]));
        bmerge16(mg);
#pragma unroll
        for (int s = 0; s < 16; ++s) lst[half][s] = mg[s];
    }
    float c16[16];
#pragma unroll
    for (int s = 0; s < 16; ++s) c16[s] = -3.0e38f;
    {
        int cnt = 0;
#pragma unroll
        for (int a = 0; a < 16; ++a)
#pragma unroll
            for (int bb = 0; bb < 16; ++bb) if ((a + 1) * (bb + 1) <= 16) {
                if ((cnt & 1) == 0) {
                    int a2 = a, b2 = bb + 1; if ((a2 + 1) * (b2 + 1) > 16) { a2 = a + 1; b2 = 0; }
                    const bool has2 = (a2 < 16);
                    const float v0 = packlow(lst[0][a] + lst[1][bb], (unsigned)((a << 4) | bb), 255u);
                    const float v1 = has2 ? packlow(lst[0][a2 & 15] + lst[1][b2 & 15], (unsigned)(((a2 & 15) << 4) | (b2 & 15)), 255u) : -3.0e38f;
                    insert16(c16, kk ? v1 : v0);
                }
                ++cnt;
            }
    }
    float win[16];
#pragma unroll
    for (int s = 0; s < 16; ++s) win[s] = __builtin_fmaxf(c16[s], xor32(c16[15 - s]));
    float mx = win[0];
#pragma unroll
    for (int s = 1; s < 16; ++s) mx = __builtin_fmaxf(mx, win[s]);
    float e[16], es = 0.f;
#pragma unroll
    for (int s = 0; s < 16; ++s) { e[s] = __expf(win[s] - mx); es += e[s]; }
    const float inv = 1.0f / es;
    if (kk == 0) {
#pragma unroll
        for (int s = 0; s < 16; ++s) {
            const unsigned ab = f2u(win[s]) & 255u, a = ab >> 4, bb = ab & 15u;
            unsigned i1 = 0, i2 = 0;
#pragma unroll
            for (int q = 0; q < 16; ++q) { i1 = (a == (unsigned)q) ? (f2u(lst[0][q]) & 127u) : i1; i2 = (bb == (unsigned)q) ? (f2u(lst[1][q]) & 127u) : i2; }
            const unsigned id = i1 * NK + i2;
            v4u en; en.x = id << 7; en.y = f2u(e[s] * inv); en.z = f2u(SU[id]); en.w = f2u(SU[16384 + id]);
            *(LAS v4u*)(F.lds + (x >> 2) * 8192 + ((x & 3) * 128 + h * 16 + s) * 16) = en;
            asm volatile("" ::: "memory");
        }
    }
}
}
__device__ __forceinline__ void p9_topk_mfma(Frame& F) {
    for (int tile = blockIdx.x; tile < T / 32; tile += F.G) tk::topk_item(F, tile, F.wave);
}

typedef unsigned v4u_ __attribute__((ext_vector_type(4)));
using bf16x2_t = __attribute__((ext_vector_type(2))) __bf16;
__device__ __forceinline__ float dot2bf(unsigned a, unsigned b, float c) { return __builtin_amdgcn_fdot2_f32_bf16(__builtin_bit_cast(bf16x2_t, a), __builtin_bit_cast(bf16x2_t, b), c, false); }
constexpr int NPASS = 32, SLICE_BYTES = 16384 * 128;


constexpr int CONV_SPLIT = 26624;
constexpr int NPASSU = 8;
constexpr int NPASSQ = 16, SLICEQ_BYTES = 16384 * 128;
__device__ __forceinline__ void p9_convert_tables_q(Frame& F, int row_lo, int row_hi, int wg, int nwg) {
    const float* const p_pv = F.ptr<const float>(PPV);
    const float* const p_pu = F.ptr<const float>(PPU);

    const int gw = wg * NWAVES + F.wave, NGW = nwg * NWAVES, lane = F.lane;
    for (int r = row_lo + gw; r < row_hi; r += NGW) {
        const int tbl = r >> 14, e = r & 16383;
        const f32x4* src = (const f32x4*)((tbl ? p_pv : p_pu) + (size_t)e * DM) + lane;
        unsigned char* dst = F.ws + (tbl ? WS_VT8 : WS_UT8) + (size_t)e * 128 + (size_t)(lane >> 5) * SLICEQ_BYTES + (lane & 31) * 4;
        f32x4 v[8];
#pragma unroll
        for (int j = 0; j < 8; ++j) v[j] = src[64 * j];
        if (tbl == 0) {
            float ss = 0.f;
#pragma unroll
            for (int j = 0; j < 8; ++j) ss += (v[j].x * v[j].x + v[j].y * v[j].y) + (v[j].z * v[j].z + v[j].w * v[j].w);
            ss = wave_sum(ss);
            const float step = fmaxf(0.335f * sqrtf(ss * (1.0f / 2048.0f)), 1e-30f), qs = 1.0f / step;
            unsigned char* dst4 = F.ws + WS_UT8 + (size_t)e * 128 + (size_t)(lane >> 1) * 4;
#pragma unroll
            for (int j = 0; j < 8; ++j) {
                const int q0 = min(max((int)floorf(v[j].x * qs + 8.0f), 0), 15), q1 = min(max((int)floorf(v[j].y * qs + 8.0f), 0), 15), q2 = min(max((int)floorf(v[j].z * qs + 8.0f), 0), 15), q3 = min(max((int)floorf(v[j].w * qs + 8.0f), 0), 15);
                const unsigned mine = (unsigned)q0 | ((unsigned)q1 << 8) | ((unsigned)q2 << 16) | ((unsigned)q3 << 24);
                const unsigned other = (unsigned)__shfl_xor((int)mine, 1);
                if ((lane & 1) == 0) *(unsigned*)(dst4 + (size_t)j * SLICEQ_BYTES) = mine | (other << 4); }
            if (lane == 0) ((float*)(F.ws + WS_SU))[e] = step;
        } else {
            float ss = 0.f;
#pragma unroll
            for (int j = 0; j < 8; ++j) ss += (v[j].x * v[j].x + v[j].y * v[j].y) + (v[j].z * v[j].z + v[j].w * v[j].w);
            ss = wave_sum(ss);
            const float sc = fmaxf(0.5f * sqrtf(ss * (1.0f / 2048.0f)), 1e-30f), qs = 1.0f / sc;
            unsigned char* dst4 = F.ws + WS_VT8 + (size_t)e * 128 + (size_t)(lane >> 1) * 4;
#pragma unroll
            for (int j = 0; j < 8; ++j) {
                unsigned r = 0u;
                r = __builtin_amdgcn_cvt_scalef32_pk_fp4_f32(r, v[j].x * qs, v[j].y * qs, 1.0f, 0);
                r = __builtin_amdgcn_cvt_scalef32_pk_fp4_f32(r, v[j].z * qs, v[j].w * qs, 1.0f, 1);
                const unsigned mine = r & 0xffffu;
                const unsigned other = (unsigned)__shfl_xor((int)mine, 1);
                if ((lane & 1) == 0) *(unsigned*)(dst4 + (size_t)j * SLICEQ_BYTES) = mine | (other << 16); }
            if (lane == 0) ((float*)(F.ws + WS_SU))[16384 + e] = sc;
        }
    }
}

typedef float f32x2_ __attribute__((ext_vector_type(2)));
__device__ __forceinline__ void p10_peer_q(Frame& F) {
    const float* const p_ln2_g = F.ptr<const float>(PLN2_G);
    const float* const p_ln2_b = F.ptr<const float>(PLN2_B);
    float* const p_out = F.ptr<float>(POUT);

    const int lane = F.lane, slot = lane >> 3, piece = lane & 7;
    LAS v4u* ent = (LAS v4u*)(F.lds + F.wave * 8192);
    const int pc16 = piece * 16;
    const __amdgpu_buffer_rsrc_t rsWS = __builtin_amdgcn_make_buffer_rsrc((void*)F.ws, (short)0, (int)WS_END, 0x00020000);
    const __amdgpu_buffer_rsrc_t rsG = __builtin_amdgcn_make_buffer_rsrc((void*)p_ln2_g, (short)0, DM * 4, 0x00020000);
    const __amdgpu_buffer_rsrc_t rsB = __builtin_amdgcn_make_buffer_rsrc((void*)p_ln2_b, (short)0, DM * 4, 0x00020000);
    const __amdgpu_buffer_rsrc_t rsO = __builtin_amdgcn_make_buffer_rsrc((void*)p_out, (short)0, T * DM * 4, 0x00020000);
    for (int tile = blockIdx.x; tile < T / 32; tile += F.G) {
        const int tw0 = tile * 32 + F.wave * 4;
        LDS_WAIT(); asm volatile("" ::: "memory");
        const LAS unsigned* idl = (const LAS unsigned*)(ent + slot);
        const LAS v4u* enl = (const LAS v4u*)(ent + slot);
        const LAS v2u* en2 = (const LAS v2u*)(ent + slot);
#define UQ_ISSUE(buf, bb, so_) do { unsigned vo_[8]; asm volatile("" ::: "memory"); _Pragma("unroll") for (int q = 0; q < 8; ++q) vo_[q] = idl[32 * ((bb) * 8 + q)]; asm volatile("" ::: "memory"); \
            _Pragma("unroll") for (int q = 0; q < 8; ++q) buf[q] = __builtin_bit_cast(v4u, __builtin_amdgcn_raw_buffer_load_b128(rsWS, (int)(vo_[q] + pc16), (int)WS_UT8 + (so_), 0)); } while (0)
#define VQ_ISSUE(buf, cbuf, bb, so_) do { v2u en_[8]; asm volatile("" ::: "memory"); _Pragma("unroll") for (int q = 0; q < 8; ++q) en_[q] = en2[16 * ((bb) * 8 + q)]; asm volatile("" ::: "memory"); \
            _Pragma("unroll") for (int q = 0; q < 8; ++q) { cbuf[q] = u2f(en_[q].y); buf[q] = __builtin_bit_cast(v4u, __builtin_amdgcn_raw_buffer_load_b128(rsWS, (int)(en_[q].x + pc16), (int)WS_VT8 + (so_), 0)); } } while (0)
        {
            int acc[64];
#pragma unroll
            for (int i = 0; i < 64; ++i) acc[i] = 0;
            int sumx[4] = {0, 0, 0, 0};
            LAS unsigned char* xl = F.lds + 65536 + F.wave * 8192;
#pragma unroll
            for (int k = 0; k < 8; ++k) { const v4u t = __builtin_bit_cast(v4u, __builtin_amdgcn_raw_buffer_load_b128(rsWS, lane * 16, (int)WS_H1Q + (tw0 + (k >> 1)) * DM + (k & 1) * 1024, 0));
                *(LAS v4u*)(xl + (k >> 1) * 2048 + (k & 1) * 1024 + lane * 16) = t; }
            LDS_WAIT(); asm volatile("" ::: "memory");
            v4u wb[2][8]; v4u xa, xb;
            UQ_ISSUE(wb[0], 0, 0);
#pragma unroll 1
            for (int p = 0; p < NPASSU; ++p) {
                const int soff = p * SLICEQ_BYTES; const int pn = (p + 1 < NPASSU) ? p + 1 : p;
#pragma unroll
                for (int b = 0; b < 8; ++b) {
                    if (b < 7) UQ_ISSUE(wb[(b + 1) & 1], b + 1, soff); else UQ_ISSUE(wb[0], 0, pn * SLICEQ_BYTES);
                    if ((b & 1) == 0) { const LAS v4u* xp = (const LAS v4u*)(xl + (b >> 1) * 2048 + 256 * p + 32 * piece); xa = xp[0]; xb = xp[1];
                        int sx = sumx[b >> 1];
                        sx = __builtin_amdgcn_sdot4((int)xa.x, 0x01010101, sx, false); sx = __builtin_amdgcn_sdot4((int)xa.y, 0x01010101, sx, false); sx = __builtin_amdgcn_sdot4((int)xa.z, 0x01010101, sx, false); sx = __builtin_amdgcn_sdot4((int)xa.w, 0x01010101, sx, false);
                        sx = __builtin_amdgcn_sdot4((int)xb.x, 0x01010101, sx, false); sx = __builtin_amdgcn_sdot4((int)xb.y, 0x01010101, sx, false); sx = __builtin_amdgcn_sdot4((int)xb.z, 0x01010101, sx, false); sx = __builtin_amdgcn_sdot4((int)xb.w, 0x01010101, sx, false);
                        sumx[b >> 1] = sx; }
                    __builtin_amdgcn_sched_barrier(0);
#pragma unroll
                    for (int q = 0; q < 8; ++q) { const int i = b * 8 + q; const v4u w = wb[b & 1][q];
                        int a = acc[i];
#define U4(WW, XL, XH) { a = __builtin_amdgcn_sdot4((int)((WW) & 0x0f0f0f0fu), (int)(XL), a, false); a = __builtin_amdgcn_sdot4((int)(((WW) >> 4) & 0x0f0f0f0fu), (int)(XH), a, false); }
                        U4(w.x, xa.x, xa.y) U4(w.y, xa.z, xa.w) U4(w.z, xb.x, xb.y) U4(w.w, xb.z, xb.w)
#undef U4
                        acc[i] = a; }
                    __builtin_amdgcn_sched_barrier(0);
                }
            }
            asm volatile("" ::: "memory");
            const int p0 = lane & 1, p1 = (lane >> 1) & 1, p2 = (lane >> 2) & 1;
            float sxc[4];
#pragma unroll
            for (int tk = 0; tk < 4; ++tk) { int s = sumx[tk]; s += __shfl_xor(s, 1); s += __shfl_xor(s, 2); s += __shfl_xor(s, 4); sxc[tk] = -7.5f * (float)s; }
            const float sxl = p0 ? (p1 ? sxc[3] : sxc[2]) : (p1 ? sxc[1] : sxc[0]);
            int r16[16], r8[8];
            {   int r32[32];
#pragma unroll
                for (int k = 0; k < 32; ++k) { const int keep = p0 ? acc[32 + k] : acc[k], send = p0 ? acc[k] : acc[32 + k]; r32[k] = keep + __builtin_amdgcn_update_dpp(0, send, 0xB1, 0xf, 0xf, true); }
#pragma unroll
                for (int k = 0; k < 16; ++k) { const int keep = p1 ? r32[16 + k] : r32[k], send = p1 ? r32[k] : r32[16 + k]; r16[k] = keep + __builtin_amdgcn_update_dpp(0, send, 0x4E, 0xf, 0xf, true); } }
#pragma unroll
            for (int k = 0; k < 8; ++k) { const int keep = p2 ? r16[8 + k] : r16[k], send = p2 ? r16[k] : r16[8 + k]; r8[k] = keep + __shfl_xor(send, 4); }
            const int ibase = 32 * p0 + 16 * p1 + 8 * p2;
#pragma unroll
            for (int k = 0; k < 8; ++k) { const int i = ibase + k;
                const float gte = u2f(idl[32 * i + 1]), sue = u2f(idl[32 * i + 2]), sve = u2f(idl[32 * i + 3]); const float z = ((float)r8[k] + sxl) * sue * (8.0f / 127.0f);
                ((LAS unsigned*)(ent + slot))[32 * i + 1] = f2u(gte * gelu_tanh(z) * sve); }
            LDS_WAIT(); asm volatile("" ::: "memory");
        }
        const int b3 = (lane >> 3) & 1, b4 = (lane >> 4) & 1, b5 = (lane >> 5) & 1;
        const int dsl = 32 * piece + 16 * b5 + 8 * b4 + 4 * b3;
        float rs[4], rq[4];
#pragma unroll
        for (int tk = 0; tk < 4; ++tk) { rs[tk] = 0.f; rq[tk] = 0.f; }
        v2u hres[4]; v4u wb[2][8]; float cb[2][8];
#pragma unroll
        for (int tk = 0; tk < 4; ++tk) hres[tk] = __builtin_bit_cast(v2u, __builtin_amdgcn_raw_buffer_load_b64(rsWS, dsl * 2, (int)WS_H1B + ((tw0 + tk) * DM) * 2, 0));
        VQ_ISSUE(wb[0], cb[0], 0, 0);
#pragma unroll 1
        for (int p = 0; p < NPASSU; ++p) {
            const int soff = p * SLICEQ_BYTES; const int pn = (p + 1 < NPASSU) ? p + 1 : p;
            v2u hresn[4]; f32x2_ o2[16];
#pragma unroll
            for (int b = 0; b < 8; ++b) {
                if (b < 7) VQ_ISSUE(wb[(b + 1) & 1], cb[(b + 1) & 1], b + 1, soff); else VQ_ISSUE(wb[0], cb[0], 0, pn * SLICEQ_BYTES);
                if (b == 5) {
#pragma unroll
                    for (int tk = 0; tk < 4; ++tk) hresn[tk] = __builtin_bit_cast(v2u, __builtin_amdgcn_raw_buffer_load_b64(rsWS, dsl * 2, (int)WS_H1B + ((tw0 + tk) * DM + 256 * pn) * 2, 0));
                }
                __builtin_amdgcn_sched_barrier(0);
                if ((b & 1) == 0) {
#pragma unroll
                    for (int k = 0; k < 16; ++k) o2[k] = (f32x2_){0.f, 0.f};
                }
#pragma unroll
                for (int q = 0; q < 8; ++q) { v4u w = wb[b & 1][q]; const float c = cb[b & 1][q]; const f32x2_ cc = (f32x2_){c, c};
                    asm volatile("" : "+v"(w.x), "+v"(w.y), "+v"(w.z), "+v"(w.w));
#define VQ_ACC(K, WW) { o2[4 * K] = __builtin_elementwise_fma(cc, __builtin_amdgcn_cvt_scalef32_pk_f32_fp4((WW), 1.0f, 0), o2[4 * K]); o2[4 * K + 1] = __builtin_elementwise_fma(cc, __builtin_amdgcn_cvt_scalef32_pk_f32_fp4((WW), 1.0f, 1), o2[4 * K + 1]); \
                        o2[4 * K + 2] = __builtin_elementwise_fma(cc, __builtin_amdgcn_cvt_scalef32_pk_f32_fp4((WW), 1.0f, 2), o2[4 * K + 2]); o2[4 * K + 3] = __builtin_elementwise_fma(cc, __builtin_amdgcn_cvt_scalef32_pk_f32_fp4((WW), 1.0f, 3), o2[4 * K + 3]); }
                    VQ_ACC(0, w.x) VQ_ACC(1, w.y) VQ_ACC(2, w.z) VQ_ACC(3, w.w)
#undef VQ_ACC
                    asm volatile("" : "+v"(o2[0]), "+v"(o2[1]), "+v"(o2[2]), "+v"(o2[3]), "+v"(o2[4]), "+v"(o2[5]), "+v"(o2[6]), "+v"(o2[7]), "+v"(o2[8]), "+v"(o2[9]), "+v"(o2[10]), "+v"(o2[11]), "+v"(o2[12]), "+v"(o2[13]), "+v"(o2[14]), "+v"(o2[15]));
                }
                if (b & 1) {
                    const int tk = b >> 1;
                    float s1[16], s2[8], t4[4];
#pragma unroll
                    for (int k = 0; k < 16; ++k) { const float lo_ = (k & 1) ? o2[k >> 1].y : o2[k >> 1].x, hi_ = (k & 1) ? o2[8 + (k >> 1)].y : o2[8 + (k >> 1)].x;
                        const v2u sw = __builtin_bit_cast(v2u, __builtin_amdgcn_permlane32_swap(f2u(lo_), f2u(hi_), false, false)); s1[k] = u2f(sw.x) + u2f(sw.y); }
#pragma unroll
                    for (int k = 0; k < 8; ++k) { const v2u sw = __builtin_bit_cast(v2u, __builtin_amdgcn_permlane16_swap(f2u(s1[k]), f2u(s1[8 + k]), false, false)); s2[k] = u2f(sw.x) + u2f(sw.y); }
#pragma unroll
                    for (int k = 0; k < 4; ++k) { const float keep = b3 ? s2[4 + k] : s2[k], send = b3 ? s2[k] : s2[4 + k]; t4[k] = keep + __shfl_xor(send, 8); }
                    const float r0 = ALPHA * bflo(hres[tk].x) + t4[0], r1 = ALPHA * bfhi(hres[tk].x) + t4[1], r2 = ALPHA * bflo(hres[tk].y) + t4[2], r3 = ALPHA * bfhi(hres[tk].y) + t4[3];
                    rs[tk] += (r0 + r1) + (r2 + r3); rq[tk] += (r0 * r0 + r1 * r1) + (r2 * r2 + r3 * r3);
                    v4u st; st.x = f2u(r0); st.y = f2u(r1); st.z = f2u(r2); st.w = f2u(r3);
                    __builtin_amdgcn_raw_buffer_store_b128(st, rsO, dsl * 4, ((tw0 + tk) * DM + 256 * p) * 4, 0);
                }
                __builtin_amdgcn_sched_barrier(0);
            }
#pragma unroll
            for (int tk = 0; tk < 4; ++tk) hres[tk] = hresn[tk];
        }
#undef UQ_ISSUE
#undef VQ_ISSUE
        float mean[4], rstd[4];
#pragma unroll
        for (int tk = 0; tk < 4; ++tk) { const float s = wave_sum(rs[tk]), q = wave_sum(rq[tk]); mean[tk] = s * (1.0f / DM); rstd[tk] = 1.0f / sqrtf(fmaxf(q * (1.0f / DM) - mean[tk] * mean[tk], 0.f) + LN_EPS); }
        VM_WAIT();
#pragma unroll 2
        for (int p = 0; p < NPASSU; ++p) {
            const v4u gw_ = __builtin_bit_cast(v4u, __builtin_amdgcn_raw_buffer_load_b128(rsG, dsl * 4, p * 1024, 0)), bw_ = __builtin_bit_cast(v4u, __builtin_amdgcn_raw_buffer_load_b128(rsB, dsl * 4, p * 1024, 0));
#pragma unroll
            for (int tk = 0; tk < 4; ++tk) { const v4u v = __builtin_bit_cast(v4u, __builtin_amdgcn_raw_buffer_load_b128(rsO, dsl * 4, ((tw0 + tk) * DM + 256 * p) * 4, 0));
                v4u st; st.x = f2u((u2f(v.x) - mean[tk]) * rstd[tk] * u2f(gw_.x) + u2f(bw_.x)); st.y = f2u((u2f(v.y) - mean[tk]) * rstd[tk] * u2f(gw_.y) + u2f(bw_.y));
                st.z = f2u((u2f(v.z) - mean[tk]) * rstd[tk] * u2f(gw_.z) + u2f(bw_.z)); st.w = f2u((u2f(v.w) - mean[tk]) * rstd[tk] * u2f(gw_.w) + u2f(bw_.w));
                __builtin_amdgcn_raw_buffer_store_b128(st, rsO, dsl * 4, ((tw0 + tk) * DM + 256 * p) * 4, 0); }
        }
        LDS_WAIT(); asm volatile("" ::: "memory");
    }
}

struct Args { const void* in[22]; float* out; unsigned char* ws; int ph_lo, ph_hi; };
__global__ void __launch_bounds__(NWAVES * 64, 2) fwd(Args args) {
    extern __shared__ __attribute__((aligned(16))) unsigned char lds[];
    Frame F;
    F.lds = (LAS unsigned char*)lds;
    F.MISC = (volatile LAS unsigned*)(F.lds + MISC_OFF);
    F.tid = threadIdx.x; F.lane = F.tid & 63; F.wave = __builtin_amdgcn_readfirstlane(F.tid >> 6);
    F.G = gridDim.x; { const int bx = blockIdx.x; F.vcu = (F.G % 8 == 0) ? (bx % 8) * (F.G / 8) + bx / 8 : bx; }
    unsigned char* ws = args.ws; F.ws = ws;
    F.ctl = (gu32*)(ws + WS_CTL);
    for (int u = F.tid; u < (LDS_BYTES - LDSCTL_OFF) / 4; u += NWAVES * 64) ((LAS unsigned*)(F.lds + LDSCTL_OFF))[u] = 0u;
    __syncthreads();
    if (F.tid == 0) { volatile LAS unsigned long long* t = (volatile LAS unsigned long long*)(F.lds + PTRTAB_OFF);
#pragma unroll
        for (int k = 0; k < 22; ++k) t[k] = (unsigned long long)args.in[k];
        t[POUT] = (unsigned long long)args.out; }
    __syncthreads();
    XcdBarrier bar; bar.bar = (unsigned*)(F.ctl + CW_BAR); bar.x = 0; bar.st = nullptr;
    if (MK_ONE_LAUNCH) bar = xcd_barrier_post((unsigned*)(F.ctl + CW_BAR), F.MISC + 8);
    const int lo = args.ph_lo, hi = args.ph_hi;
#define IN(k) (lo <= (k) && (k) < hi)
#define SEAM(k) do { if (MK_ONE_LAUNCH && IN(k) && IN((k) + 1)) xcd_barrier(bar); } while (0)
    if (IN(0)) { p0_prep(F); SEAM(0); }
    if (IN(1)) {
        pg8::Gemm g{(const pg8::bf16_t*)(ws + WS_XB), (const pg8::bf16_t*)(ws + WS_WIN), T, NIN, DM}; pg8::StaticOrder S; S.init(T, NIN, F.G, (int)blockIdx.x);
        pg8::EpiProj E{(pg8::bf16_t*)(ws + WS_Q), (size_t)T * 1024, (const float*)(ws + WS_ROPE), (const float*)(ws + WS_ROPE) + (size_t)T * 64, 0.08838834764831845f * 1.4426950408889634f};
        pg8::gemm_phase<pg8::EpiProj, pg8::StaticOrder, true, true>(F.lds + RING_OFF, g, S, E);
        if (F.G == 256 && blockIdx.x >= 128) { p0_late_transposes(F, (int)blockIdx.x - 128, 128); p9_convert_tables_q(F, 0, CONV_SPLIT, (int)blockIdx.x - 128, 128); }
        SEAM(1);
    }
    if (IN(3)) { p3_attn_mfma(F); p3_rec_local(F); { const bool split = (F.G == 256); p9_convert_tables_q(F, split ? CONV_SPLIT : 0, 2 * 16384, (int)blockIdx.x, F.G); } SEAM(3); }
    if (IN(5)) { p5_mix(F); SEAM(5); }
    if (IN(6)) {
        pg8::Gemm g{(const pg8::bf16_t*)(ws + WS_MIX), (const pg8::bf16_t*)(ws + WS_WOUT), T, DM, DM}; pg8::StaticOrder S; S.init(T, DM, F.G, (int)blockIdx.x);
        pg8::EpiResLn E{ws, PTRTAB_OFF, PX, PLN1_G, PLN1_B, WS_H1B, WS_H1Q, WS_XCH, WS_CTL + (size_t)CW_SEAM * 4, WS_XB, ALPHA, LN_EPS};
        pg8::gemm_phase<pg8::EpiResLn, pg8::StaticOrder, false, true>(F.lds + RING_OFF, g, S, E);
        SEAM(6);
    }
    if (IN(8)) {
        pg8::Gemm g{(const pg8::bf16_t*)(ws + WS_H1B), (const pg8::bf16_t*)(ws + WS_WQ), T, DM, DM}; pg8::StaticOrder S; S.init(T, DM, F.G, (int)blockIdx.x);
        pg8::EpiBf16Plain E{(pg8::bf16_t*)(ws + WS_Q2), DM};
        pg8::gemm_phase<pg8::EpiBf16Plain, pg8::StaticOrder, true, true>(F.lds + RING_OFF, g, S, E);
        SEAM(8);
    }
    if (IN(9)) { p9_topk_mfma(F); LDS_WAIT(); __syncthreads(); }
    if (IN(10)) { p10_peer_q(F); }
#undef IN
#undef SEAM
}

extern "C" void kernel_launch(void* const* d_in, const int* in_sizes, int n_in, void* d_out, int out_size, void* d_ws, size_t ws_size, hipStream_t stream) {
    static int grid = 0;
    if (grid == 0) {
        if (n_in != 22 || out_size != T * DM || ws_size < WS_END) { fprintf(stderr, "kernel_launch: unexpected shapes: n_in %d out %d ws %zu\n", n_in, out_size, ws_size); grid = -1; return; }
        int dev = 0, cus = 0, per_cu = 0;
        if (hipGetDevice(&dev) != hipSuccess || hipDeviceGetAttribute(&cus, hipDeviceAttributeMultiprocessorCount, dev) != hipSuccess) { grid = -1; return; }
        if (hipFuncSetAttribute((const void*)fwd, hipFuncAttributeMaxDynamicSharedMemorySize, LDS_BYTES) != hipSuccess) { fprintf(stderr, "kernel_launch: hipFuncSetAttribute failed\n"); grid = -1; return; }
        if (hipOccupancyMaxActiveBlocksPerMultiprocessor(&per_cu, (const void*)fwd, NWAVES * 64, LDS_BYTES) != hipSuccess || per_cu < 1) fprintf(stderr, "kernel_launch: occupancy query reports %d\n", per_cu);
        (void)hipGetLastError();
        grid = cus;
    }
    if (grid < 0) return;
    if (hipMemsetAsync((char*)d_ws + WS_CTL, 0, CTL_ZERO_BYTES, stream) != hipSuccess) return;
    Args a{};
    for (int i = 0; i < 22; ++i) a.in[i] = d_in[i];
    a.out = (float*)d_out; a.ws = (unsigned char*)d_ws;
#if MK_ONE_LAUNCH
    a.ph_lo = 0; a.ph_hi = NPH;
    hipLaunchKernelGGL(fwd, dim3(grid), dim3(NWAVES * 64), LDS_BYTES, stream, a);
#else
    for (int p = 0; p < NPH; ++p) { a.ph_lo = p; a.ph_hi = p + 1; hipLaunchKernelGGL(fwd, dim3(grid), dim3(NWAVES * 64), LDS_BYTES, stream, a); }
#endif
}
```

```cpp
#include <hip/hip_runtime.h>
#include <cstdio>
#include <cstdint>
namespace pg8 {
#define PG8_LAS __attribute__((address_space(3)))
typedef unsigned short bf16_t;
typedef short bf16x8 __attribute__((ext_vector_type(8)));
typedef float f32x4 __attribute__((ext_vector_type(4)));
typedef unsigned u32x4 __attribute__((ext_vector_type(4)));
constexpr int BM = 256, BK = 64, HALF = 128, HTB = HALF * BK * 2  , STAGE_BYTES = 8 * HTB, NXCD = 8, WGM = 8;

__host__ __device__ __forceinline__ int lds_byte(int r, int c) { const int st = (r >> 4) * 2 + (c >> 5), rr = r & 15, cc = c & 31, ob = rr * 64 + cc * 2; return st * 1024 + (ob ^ (((ob >> 9) & 1) << 5)); }
__host__ __device__ __forceinline__ void stage_rc(int b, int& R, int& C) { const int st = b / 1024, sb = b % 1024, swz = sb ^ (((sb >> 9) & 1) << 5); R = (st >> 1) * 16 + swz / 64; C = (st & 1) * 32 + (swz % 64) / 2; }
__host__ __device__ __forceinline__ int perm32(int rho) { const int n = rho >> 4, i = rho & 15; return 8 * (i >> 2) + 4 * n + (i & 3); }

struct Unit { int pm, pn; };
struct Gemm { const bf16_t* A; const bf16_t* Bt; int M, N, K; };

struct StaticOrder {
    int nM, nN, nwg, G, c;
    __host__ __device__ void init(int M, int N, int G_, int c_) { nM = M / BM; nN = N / BM; nwg = nM * nN; G = G_; c = c_; }
    __host__ __device__ bool next(int i, Unit& u) const {
        const long L = (long)i * G + c; if (L >= nwg) return false;
        int wgid = (int)L; { const int q = nwg / NXCD, r = nwg % NXCD, xcd = wgid % NXCD, off = wgid / NXCD; wgid = (xcd < r ? xcd * (q + 1) : r * (q + 1) + (xcd - r) * q) + off; }
        const int nig = WGM * nN, gid = wgid / nig, fm = gid * WGM, gsz = (nM - fm) < WGM ? (nM - fm) : WGM;
        u.pm = fm + ((wgid % nig) % gsz); u.pn = (wgid % nig) / gsz; return true;
    }
    __device__ __forceinline__ void a_ready(const Unit&) const {}
    __device__ __forceinline__ void done(const Unit&) const {}
};
__device__ __forceinline__ unsigned cvt_pk_bf16(float lo, float hi) { unsigned r; asm volatile("s_nop 1\n\tv_cvt_pk_bf16_f32 %0, %1, %2" : "=v"(r) : "v"(lo), "v"(hi)); return r; }
struct EpiF32 {
    static constexpr bool PERM = false, AFTER_DRAIN = false;
    float* C; int ldc;
    __device__ __forceinline__ void operator()(const f32x4 (&acc)[2][2][4][2], const Unit& u, int wr, int wc, int fr, int fq) const {
        const int row0 = u.pm * BM + wr * 64 + fr, col0 = u.pn * BM + wc * 32 + 4 * fq;
#pragma unroll
        for (int ai = 0; ai < 2; ++ai)
#pragma unroll
            for (int m = 0; m < 4; ++m) { float* rowp = C + (size_t)(row0 + ai * HALF + m * 16) * ldc + col0;
#pragma unroll
                for (int bj = 0; bj < 2; ++bj)
#pragma unroll
                    for (int n = 0; n < 2; ++n) *(f32x4*)(rowp + bj * HALF + n * 16) = acc[ai][bj][m][n]; }
    }
    __device__ __forceinline__ void fused(f32x4 (&acc)[2][2][4][2], const Unit& u, int wr, int wc, int fr, int fq, PG8_LAS unsigned char* lds, int wid, int lane) const {}
};

__device__ __forceinline__ float gelu_tanh_e(float x) { const float u = 0.7978845608028654f * (x + 0.044715f * x * x * x); return x * __builtin_amdgcn_rcpf(1.0f + __expf(-2.0f * u)); }
struct EpiProj {
    static constexpr bool PERM = true, AFTER_DRAIN = false;
    bf16_t* O; size_t sec_stride; const float* ct; const float* st; float scale0;
    __device__ __forceinline__ void operator()(const f32x4 (&acc)[2][2][4][2], const Unit& u, int wr, int wc, int fr, int fq) const {
        const int row0 = u.pm * BM + wr * 64 + fr; const int sec = u.pn >> 2; const int col0 = (u.pn & 3) * BM + wc * 32 + 8 * fq;
        bf16_t* base = O + (size_t)sec * sec_stride;
        const int g4 = 4 * (4 * wc + fq);
#pragma unroll
        for (int ai = 0; ai < 2; ++ai)
#pragma unroll
            for (int m = 0; m < 4; ++m) { const int row = row0 + ai * HALF + m * 16; bf16_t* rowp = base + (size_t)row * 1024 + col0;
                f32x4 c4 = (f32x4){1.f, 1.f, 1.f, 1.f}, s4 = (f32x4){0.f, 0.f, 0.f, 0.f};
                if (sec < 2) { c4 = *(const f32x4*)(ct + (size_t)row * 64 + g4); s4 = *(const f32x4*)(st + (size_t)row * 64 + g4); }
#pragma unroll
                for (int bj = 0; bj < 2; ++bj) { f32x4 v0 = acc[ai][bj][m][0], v1 = acc[ai][bj][m][1];
                    if (sec < 2) { const f32x4 o0 = v0 * c4 - v1 * s4, o1 = v1 * c4 + v0 * s4; const float sc = (sec == 0) ? scale0 : 1.0f; v0 = o0 * sc; v1 = o1 * sc; }
                    if (sec == 4) { v0 = (f32x4){gelu_tanh_e(v0[0]), gelu_tanh_e(v0[1]), gelu_tanh_e(v0[2]), gelu_tanh_e(v0[3])}; v1 = (f32x4){gelu_tanh_e(v1[0]), gelu_tanh_e(v1[1]), gelu_tanh_e(v1[2]), gelu_tanh_e(v1[3])}; }
                    u32x4 w; w.x = cvt_pk_bf16(v0[0], v0[1]); w.y = cvt_pk_bf16(v0[2], v0[3]); w.z = cvt_pk_bf16(v1[0], v1[1]); w.w = cvt_pk_bf16(v1[2], v1[3]);
                    *(u32x4*)(rowp + bj * HALF) = w; } }
    }
    __device__ __forceinline__ void fused(f32x4 (&acc)[2][2][4][2], const Unit& u, int wr, int wc, int fr, int fq, PG8_LAS unsigned char* lds, int wid, int lane) const {}
};

struct PanelStats8 {
    unsigned* xbuf;
    unsigned* cnt;
    float eps;
    __device__ __forceinline__ void run(const f32x4 (&v)[2][2][4][2], const Unit& u, int wr, int wc, int fr, int fq, PG8_LAS unsigned char* lds, int wid, int lane) const {
        typedef float f32x2v __attribute__((ext_vector_type(2)));
        PG8_LAS f32x2v* P = (PG8_LAS f32x2v*)lds;
        PG8_LAS f32x2v* S = (PG8_LAS f32x2v*)(lds + 8192);
#pragma unroll
        for (int ai = 0; ai < 2; ++ai)
#pragma unroll
            for (int m = 0; m < 4; ++m) {
                float s = 0.f;
#pragma unroll
                for (int bj = 0; bj < 2; ++bj)
#pragma unroll
                    for (int n = 0; n < 2; ++n) { const f32x4 x = v[ai][bj][m][n]; s += (x[0] + x[1]) + (x[2] + x[3]); }
                s += __shfl_xor(s, 16); s += __shfl_xor(s, 32);
                const float mw = s * (1.0f / 64.0f); float q = 0.f;
#pragma unroll
                for (int bj = 0; bj < 2; ++bj)
#pragma unroll
                    for (int n = 0; n < 2; ++n) { const f32x4 d = v[ai][bj][m][n] - mw; q += (d[0] * d[0] + d[1] * d[1]) + (d[2] * d[2] + d[3] * d[3]); }
                q += __shfl_xor(q, 16); q += __shfl_xor(q, 32);
                if (fq == 0) P[(ai * HALF + wr * 64 + m * 16 + fr) * 4 + wc] = (f32x2v){mw, q};
            }
        asm volatile("s_waitcnt lgkmcnt(0)" ::: "memory"); __builtin_amdgcn_s_barrier(); asm volatile("" ::: "memory");
        const int row = wid * 32 + (lane & 31);
        if (lane < 32) {
            const f32x2v a = P[row * 4 + 0], b = P[row * 4 + 1], c = P[row * 4 + 2], d = P[row * 4 + 3];
            const float mt = (a.x + b.x + c.x + d.x) * 0.25f;
            const float da = a.x - mt, db = b.x - mt, dc = c.x - mt, dd = d.x - mt;
            const float m2 = (a.y + b.y) + (c.y + d.y) + 64.0f * ((da * da + db * db) + (dc * dc + dd * dd));
            unsigned long long* slot = (unsigned long long*)xbuf + ((size_t)(u.pm * 8 + u.pn) * BM + row);
            __hip_atomic_store(slot, ((unsigned long long)__float_as_uint(m2) << 32) | __float_as_uint(mt), __ATOMIC_RELAXED, __HIP_MEMORY_SCOPE_AGENT);
        }
        asm volatile("s_waitcnt vmcnt(0)" ::: "memory");
        if (lane == 0) __hip_atomic_fetch_add(cnt + 64 * u.pm, 1u, __ATOMIC_RELAXED, __HIP_MEMORY_SCOPE_AGENT);
        if (wid == 0) {
            unsigned spins = 0;
            while ((unsigned)__builtin_amdgcn_readfirstlane(__hip_atomic_load(cnt + 64 * u.pm, __ATOMIC_RELAXED, __HIP_MEMORY_SCOPE_AGENT)) < 64u) { __builtin_amdgcn_s_sleep(2); if (++spins > (1u << 22)) break; }
            __builtin_amdgcn_fence(__ATOMIC_ACQUIRE, "agent");
        }
        asm volatile("s_waitcnt vmcnt(0) lgkmcnt(0)" ::: "memory"); __builtin_amdgcn_s_barrier(); asm volatile("" ::: "memory");
        if (lane < 32) {
            const unsigned long long* slot = (const unsigned long long*)xbuf + (size_t)(u.pm * 8) * BM + row; float mt[8], m2[8]; float ms = 0.f;
#pragma unroll
            for (int t = 0; t < 8; ++t) { const unsigned long long w = __hip_atomic_load(slot + t * BM, __ATOMIC_RELAXED, __HIP_MEMORY_SCOPE_AGENT); mt[t] = __uint_as_float((unsigned)w); m2[t] = __uint_as_float((unsigned)(w >> 32)); ms += mt[t]; }
            const float mean = ms * 0.125f; float q = 0.f;
#pragma unroll
            for (int t = 0; t < 8; ++t) { const float dm = mt[t] - mean; q += m2[t] + 256.0f * dm * dm; }
            S[row] = (f32x2v){mean, 1.0f / sqrtf(q * (1.0f / 2048.0f) + eps)};
        }
        asm volatile("s_waitcnt lgkmcnt(0)" ::: "memory"); __builtin_amdgcn_s_barrier(); asm volatile("" ::: "memory");
    }
};
struct EpiResLn {
    static constexpr bool PERM = false, AFTER_DRAIN = true;
    unsigned char* ws; int ptab_off, i_resid, i_g, i_b; size_t off_hb, off_hq, off_xch, off_cnt, off_xb; float alpha, eps;
    __device__ __forceinline__ const float* tabptr(PG8_LAS unsigned char* lds, int k) const {
        volatile PG8_LAS unsigned* t = (volatile PG8_LAS unsigned*)(lds + ptab_off) + 2 * k;
        const unsigned lo = (unsigned)__builtin_amdgcn_readfirstlane((int)t[0]), hi = (unsigned)__builtin_amdgcn_readfirstlane((int)t[1]);
        return (const float*)(__attribute__((address_space(1))) const float*)(((unsigned long long)hi << 32) | lo);
    }
    __device__ __forceinline__ void operator()(const f32x4 (&acc)[2][2][4][2], const Unit& u, int wr, int wc, int fr, int fq) const {}
    __device__ __forceinline__ void fused(f32x4 (&acc)[2][2][4][2], const Unit& u, int wr, int wc, int fr, int fq, PG8_LAS unsigned char* lds, int wid, int lane) const {
        typedef float f32x2v __attribute__((ext_vector_type(2))); typedef unsigned u32x2v __attribute__((ext_vector_type(2)));
        const PG8_LAS f32x2v* S = (const PG8_LAS f32x2v*)(lds + 8192);
        const int col0 = u.pn * BM + wc * 32 + 4 * fq;
        const int vo = (u.pm * BM + wr * 64 + fr) * 2048 + col0;
        const bool oddq = (fq & 1) != 0;
        {
            const bf16_t* resid = (const bf16_t*)(ws + off_xb) + vo + (oddq ? 12 : 0);
            typedef unsigned u32x4r __attribute__((ext_vector_type(4))); typedef unsigned u32x2r __attribute__((ext_vector_type(2)));
#pragma unroll
            for (int ai = 0; ai < 2; ++ai)
#pragma unroll
                for (int m = 0; m < 4; ++m) { const bf16_t* rp = resid + (ai * HALF + m * 16) * 2048;
#pragma unroll
                    for (int bj = 0; bj < 2; ++bj) { const u32x4r L = *(const u32x4r*)(rp + bj * HALF);
                        const u32x2r sx = __builtin_bit_cast(u32x2r, __builtin_amdgcn_permlane16_swap(L.x, L.z, false, false)), sy = __builtin_bit_cast(u32x2r, __builtin_amdgcn_permlane16_swap(L.y, L.w, false, false));
                        const unsigned w0x = sx.x, w0y = sy.x, w1x = sx.y, w1y = sy.y;
                        const f32x4 r0 = (f32x4){__uint_as_float(w0x << 16), __uint_as_float(w0x & 0xffff0000u), __uint_as_float(w0y << 16), __uint_as_float(w0y & 0xffff0000u)};
                        const f32x4 r1 = (f32x4){__uint_as_float(w1x << 16), __uint_as_float(w1x & 0xffff0000u), __uint_as_float(w1y << 16), __uint_as_float(w1y & 0xffff0000u)};
                        acc[ai][bj][m][0] += r0 * alpha; acc[ai][bj][m][1] += r1 * alpha; }
                    asm volatile("" : "+v"(acc[ai][0][m][0]), "+v"(acc[ai][0][m][1]), "+v"(acc[ai][1][m][0]), "+v"(acc[ai][1][m][1]));
                    asm volatile("" ::: "memory"); } }
        { const PanelStats8 st{(unsigned*)(ws + off_xch), (unsigned*)(ws + off_cnt), eps}; st.run(acc, u, wr, wc, fr, fq, lds, wid, lane); }
        const float* g = tabptr(lds, i_g); const float* b = tabptr(lds, i_b);
        const __amdgpu_buffer_rsrc_t rsW = __builtin_amdgcn_make_buffer_rsrc((void*)ws, (short)0, 512 << 20, 0x00020000);
#pragma unroll
        for (int bj = 0; bj < 2; ++bj) {
            const f32x4 g0 = *(const f32x4*)(g + col0 + bj * HALF), g1 = *(const f32x4*)(g + col0 + bj * HALF + 16), b0 = *(const f32x4*)(b + col0 + bj * HALF), b1 = *(const f32x4*)(b + col0 + bj * HALF + 16);
#pragma unroll
            for (int ai = 0; ai < 2; ++ai)
#pragma unroll
                for (int m = 0; m < 4; ++m) { const int r = ai * HALF + wr * 64 + m * 16 + fr; const f32x2v sr = S[r]; const int so = (ai * HALF + m * 16) * 2048;
                    const f32x4 h0 = (acc[ai][bj][m][0] - sr.x) * sr.y * g0 + b0, h1 = (acc[ai][bj][m][1] - sr.x) * sr.y * g1 + b1;
                    u32x2v w0; w0.x = cvt_pk_bf16(h0[0], h0[1]); w0.y = cvt_pk_bf16(h0[2], h0[3]); u32x2v w1; w1.x = cvt_pk_bf16(h1[0], h1[1]); w1.y = cvt_pk_bf16(h1[2], h1[3]);
                    __builtin_amdgcn_raw_buffer_store_b64(w0, rsW, vo * 2 + bj * 256, (int)off_hb + so * 2, 0);
                    __builtin_amdgcn_raw_buffer_store_b64(w1, rsW, vo * 2 + bj * 256 + 32, (int)off_hb + so * 2, 0);
                    const float qs = 127.0f / 8.0f;
                    const f32x4 c0 = __builtin_elementwise_min(__builtin_elementwise_max(h0 * qs, (f32x4){-127.f, -127.f, -127.f, -127.f}), (f32x4){127.f, 127.f, 127.f, 127.f});
                    const f32x4 c1 = __builtin_elementwise_min(__builtin_elementwise_max(h1 * qs, (f32x4){-127.f, -127.f, -127.f, -127.f}), (f32x4){127.f, 127.f, 127.f, 127.f});
                    const unsigned q0 = ((unsigned)(int)rintf(c0[0]) & 255u) | (((unsigned)(int)rintf(c0[1]) & 255u) << 8) | (((unsigned)(int)rintf(c0[2]) & 255u) << 16) | (((unsigned)(int)rintf(c0[3]) & 255u) << 24);
                    const unsigned q1 = ((unsigned)(int)rintf(c1[0]) & 255u) | (((unsigned)(int)rintf(c1[1]) & 255u) << 8) | (((unsigned)(int)rintf(c1[2]) & 255u) << 16) | (((unsigned)(int)rintf(c1[3]) & 255u) << 24);
                    {
                        const u32x2v sq = __builtin_bit_cast(u32x2v, __builtin_amdgcn_permlane16_swap(q0, q1, false, false));
                        __builtin_amdgcn_raw_buffer_store_b64(sq, rsW, vo + bj * 128 + ((fq & 1) ? 12 : 0), (int)off_hq + so, 0); }
                    asm volatile("" ::: "memory"); }
        }
    }
};

struct EpiBf16Plain {
    static constexpr bool PERM = true, AFTER_DRAIN = false;
    bf16_t* O; int ldc;
    __device__ __forceinline__ void operator()(const f32x4 (&acc)[2][2][4][2], const Unit& u, int wr, int wc, int fr, int fq) const {
        const int row0 = u.pm * BM + wr * 64 + fr, col0 = u.pn * BM + wc * 32 + 8 * fq;
#pragma unroll
        for (int ai = 0; ai < 2; ++ai)
#pragma unroll
            for (int m = 0; m < 4; ++m) { bf16_t* rowp = O + (size_t)(row0 + ai * HALF + m * 16) * ldc + col0;
#pragma unroll
                for (int bj = 0; bj < 2; ++bj) { const f32x4 v0 = acc[ai][bj][m][0], v1 = acc[ai][bj][m][1];
                    u32x4 w; w.x = cvt_pk_bf16(v0[0], v0[1]); w.y = cvt_pk_bf16(v0[2], v0[3]); w.z = cvt_pk_bf16(v1[0], v1[1]); w.w = cvt_pk_bf16(v1[2], v1[3]);
                    *(u32x4*)(rowp + bj * HALF) = w; } }
    }
    __device__ __forceinline__ void fused(f32x4 (&acc)[2][2][4][2], const Unit& u, int wr, int wc, int fr, int fq, PG8_LAS unsigned char* lds, int wid, int lane) const {}
};
template <class Epi, class Sched, bool ALIGN_EPI = false, bool SP2 = false>
__device__ __forceinline__ void gemm_phase(PG8_LAS unsigned char* lds, const Gemm g, const Sched& S, const Epi& E) {
    const int tid = threadIdx.x, wid = __builtin_amdgcn_readfirstlane(tid >> 6), lane = tid & 63, wr = wid >> 2, wc = wid & 3, fr = lane & 15, fq = lane >> 4;
    const int K = g.K, nt = K / BK;
    unsigned voffA[2], voffB[2];
#pragma unroll
    for (int i = 0; i < 2; ++i) { int R, C; stage_rc(tid * 16 + i * 8192, R, C); const int Rb = Epi::PERM ? ((R & ~31) + perm32(R & 31)) : R;
        voffA[i] = (unsigned)(R * K + C) * 2u; voffB[i] = (unsigned)(Rb * K + C) * 2u; }
    const size_t kstep = (size_t)(BK * 2);
    const size_t hstep = (size_t)HALF * K * 2;
    const size_t tstep = 2 * hstep;
    const unsigned ldsw = (unsigned)wid * 1024u;
    const int aoff = lds_byte(wr * 64 + fr, fq * 8), boff = lds_byte(wc * 32 + fr, fq * 8);
#define PG8_SA(b, h) (((b) * 2 + (h)) * HTB)
#define PG8_SB(b, h) ((4 + (b) * 2 + (h)) * HTB)
#define PG8_STAGE(bufoff, gbase, voff) do { _Pragma("unroll") for (int _i = 0; _i < 2; ++_i) \
        __builtin_amdgcn_global_load_lds((const unsigned*)((const char*)(gbase) + (voff)[_i]), (PG8_LAS unsigned*)(lds + (bufoff) + ldsw + _i * 8192), 16, 0, 0); } while (0)
#define PG8_LDA(dst, b, h) do { _Pragma("unroll") for (int m = 0; m < 4; ++m) _Pragma("unroll") for (int k = 0; k < 2; ++k) dst[m][k] = *(const PG8_LAS bf16x8*)(lds + PG8_SA(b, h) + aoff + m * 2048 + k * 1024); } while (0)
#define PG8_LDB(dst, b, h) do { _Pragma("unroll") for (int n = 0; n < 2; ++n) _Pragma("unroll") for (int k = 0; k < 2; ++k) dst[n][k] = *(const PG8_LAS bf16x8*)(lds + PG8_SB(b, h) + boff + n * 2048 + k * 1024); } while (0)
#define PG8_MMA(ai, bj, At, Bt) do { __builtin_amdgcn_s_setprio(1); _Pragma("unroll") for (int m = 0; m < 4; ++m) _Pragma("unroll") for (int n = 0; n < 2; ++n) _Pragma("unroll") for (int k = 0; k < 2; ++k) \
        acc[ai][bj][m][n] = __builtin_amdgcn_mfma_f32_16x16x32_bf16(Bt[n][k], At[m][k], acc[ai][bj][m][n], 0, 0, 0); __builtin_amdgcn_s_setprio(0); } while (0)
#define PG8_WAIT_V(n) asm volatile("s_waitcnt vmcnt(" #n ")" ::: "memory")
#define PG8_WAIT_L(n) asm volatile("s_waitcnt lgkmcnt(" #n ")" ::: "memory")
#define PG8_BAR __builtin_amdgcn_s_barrier()
#define PG8_SCHED __builtin_amdgcn_sched_barrier(0)
    Unit cur, nxt; int ui = 0;
    if (!S.next(0, cur)) return;
    f32x4 acc[2][2][4][2];
#pragma unroll
    for (int a = 0; a < 2; ++a)
#pragma unroll
        for (int b = 0; b < 2; ++b)
#pragma unroll
            for (int m = 0; m < 4; ++m)
#pragma unroll
                for (int n = 0; n < 2; ++n) acc[a][b][m][n] = (f32x4){0.f, 0.f, 0.f, 0.f};
    bf16x8 At[4][2], B0[2][2], B1[2][2];
    const char* cA = (const char*)g.A + (size_t)cur.pm * tstep; const char* cB = (const char*)g.Bt + (size_t)cur.pn * tstep;
    S.a_ready(cur);
    if constexpr (SP2) {
        PG8_STAGE(PG8_SB(0, 0), cB, voffB); PG8_STAGE(PG8_SB(0, 1), cB + hstep, voffB); PG8_STAGE(PG8_SA(0, 0), cA, voffA); PG8_STAGE(PG8_SA(0, 1), cA + hstep, voffA);
        if (wr == 1) PG8_BAR;
        PG8_WAIT_V(2); PG8_BAR;
        PG8_STAGE(PG8_SB(1, 0), cB + kstep, voffB); PG8_STAGE(PG8_SA(1, 0), cA + kstep, voffA); PG8_STAGE(PG8_SB(1, 1), cB + hstep + kstep, voffB);
        PG8_WAIT_V(6); PG8_BAR;
    } else {
        PG8_STAGE(PG8_SB(0, 0), cB, voffB); PG8_STAGE(PG8_SA(0, 0), cA, voffA); PG8_STAGE(PG8_SB(0, 1), cB + hstep, voffB); PG8_STAGE(PG8_SA(0, 1), cA + hstep, voffA);
        if (wr == 1) PG8_BAR;
        PG8_WAIT_V(4); PG8_BAR;
        PG8_STAGE(PG8_SB(1, 0), cB + kstep, voffB); PG8_STAGE(PG8_SA(1, 0), cA + kstep, voffA); PG8_STAGE(PG8_SB(1, 1), cB + hstep + kstep, voffB);
        PG8_WAIT_V(6); PG8_BAR;
    }
    for (;;) {
        const bool has_next = S.next(ui + 1, nxt);
        const char* nA = has_next ? (const char*)g.A + (size_t)nxt.pm * tstep : cA; const char* nB = has_next ? (const char*)g.Bt + (size_t)nxt.pn * tstep : cB;
        for (int t = 0; t < nt; t += 2) {
            const bool last = (t == nt - 2);
            const char* a1 = cA + (size_t)(t + 1) * kstep;
            const char* a2 = last ? nA : cA + (size_t)(t + 2) * kstep; const char* b2 = last ? nB : cB + (size_t)(t + 2) * kstep;
            const char* a3 = a2 + kstep; const char* b3 = b2 + kstep;
            if (last && has_next) S.a_ready(nxt);
            if constexpr (SP2) {
            PG8_LDB(B0, 0, 0); PG8_LDB(B1, 0, 1); PG8_SCHED; PG8_LDA(At, 0, 0); PG8_STAGE(PG8_SA(1, 1), a1 + hstep, voffA);
            PG8_WAIT_V(8); PG8_WAIT_L(0); PG8_BAR; PG8_MMA(0, 0, At, B0); PG8_MMA(0, 1, At, B1); PG8_BAR; PG8_SCHED;
            PG8_LDA(At, 0, 1); PG8_STAGE(PG8_SB(0, 0), b2, voffB); PG8_STAGE(PG8_SB(0, 1), b2 + hstep, voffB); PG8_STAGE(PG8_SA(0, 0), a2, voffA);
            PG8_WAIT_V(8); PG8_WAIT_L(0); PG8_BAR; PG8_MMA(1, 0, At, B0); PG8_MMA(1, 1, At, B1); PG8_BAR; PG8_SCHED;
            PG8_LDB(B0, 1, 0); PG8_LDB(B1, 1, 1); PG8_SCHED; PG8_LDA(At, 1, 0); PG8_STAGE(PG8_SA(0, 1), a2 + hstep, voffA);
            PG8_WAIT_V(8); PG8_WAIT_L(0); PG8_BAR; PG8_MMA(0, 0, At, B0); PG8_MMA(0, 1, At, B1); PG8_BAR; PG8_SCHED;
            PG8_LDA(At, 1, 1); PG8_STAGE(PG8_SB(1, 0), b3, voffB); PG8_STAGE(PG8_SB(1, 1), b3 + hstep, voffB); PG8_STAGE(PG8_SA(1, 0), a3, voffA);
            PG8_WAIT_V(8); PG8_WAIT_L(0); PG8_BAR; PG8_MMA(1, 0, At, B0); PG8_MMA(1, 1, At, B1); PG8_BAR; PG8_SCHED;
            } else {
            PG8_LDB(B0, 0, 0); PG8_SCHED; PG8_LDA(At, 0, 0); PG8_STAGE(PG8_SA(1, 1), a1 + hstep, voffA);
            PG8_WAIT_L(8); PG8_BAR; PG8_WAIT_L(0); PG8_MMA(0, 0, At, B0); PG8_BAR; PG8_SCHED;
            PG8_LDB(B1, 0, 1); PG8_STAGE(PG8_SB(0, 0), b2, voffB);
            PG8_BAR; PG8_WAIT_L(0); PG8_MMA(0, 1, At, B1); PG8_BAR;
            PG8_LDA(At, 0, 1); PG8_STAGE(PG8_SA(0, 0), a2, voffA);
            PG8_BAR; PG8_WAIT_L(0); PG8_MMA(1, 0, At, B0); PG8_BAR; PG8_SCHED;
            PG8_STAGE(PG8_SB(0, 1), b2 + hstep, voffB);
            PG8_WAIT_V(6); PG8_BAR; PG8_MMA(1, 1, At, B1); PG8_BAR;
            PG8_LDB(B0, 1, 0); PG8_SCHED; PG8_LDA(At, 1, 0); PG8_STAGE(PG8_SA(0, 1), a2 + hstep, voffA);
            PG8_WAIT_L(8); PG8_BAR; PG8_WAIT_L(0); PG8_MMA(0, 0, At, B0); PG8_BAR; PG8_SCHED;
            PG8_LDB(B1, 1, 1); PG8_STAGE(PG8_SB(1, 0), b3, voffB);
            PG8_BAR; PG8_WAIT_L(0); PG8_MMA(0, 1, At, B1); PG8_BAR;
            PG8_LDA(At, 1, 1); PG8_STAGE(PG8_SA(1, 0), a3, voffA);
            PG8_BAR; PG8_WAIT_L(0); PG8_MMA(1, 0, At, B0); PG8_BAR; PG8_SCHED;
            PG8_STAGE(PG8_SB(1, 1), b3 + hstep, voffB);
            PG8_WAIT_V(6); PG8_BAR; PG8_MMA(1, 1, At, B1); PG8_BAR;
            }
        }
        if constexpr (ALIGN_EPI) { if (wr == 0) PG8_BAR; }
        if constexpr (!Epi::AFTER_DRAIN) { E(acc, cur, wr, wc, fr, fq); S.done(cur); }
        if (!has_next) break;
#pragma unroll
        for (int a = 0; a < 2; ++a)
#pragma unroll
            for (int b = 0; b < 2; ++b)
#pragma unroll
                for (int m = 0; m < 4; ++m)
#pragma unroll
                    for (int n = 0; n < 2; ++n) acc[a][b][m][n] = (f32x4){0.f, 0.f, 0.f, 0.f};
        cur = nxt; cA = nA; cB = nB; ++ui;
        if constexpr (ALIGN_EPI) { if (wr == 1) PG8_BAR; }
    }
    PG8_WAIT_V(0);
    if constexpr (!ALIGN_EPI) { if (wr == 0) PG8_BAR; }
    PG8_BAR;
    if constexpr (Epi::AFTER_DRAIN) { E.fused(acc, cur, wr, wc, fr, fq, lds, wid, lane); S.done(cur); }
#undef PG8_SA
#undef PG8_SB
#undef PG8_STAGE
#undef PG8_LDA
#undef PG8_LDB
#undef PG8_MMA
#undef PG8_WAIT_V
#undef PG8_WAIT_L
#undef PG8_BAR
#undef PG8_SCHED
}
}

#ifndef MK_ONE_LAUNCH
#define MK_ONE_LAUNCH 1
#endif
constexpr int NWAVES = 8, NTHR = 512;
constexpr int BATCH = 4, SEQ = 2048, DM = 2048, T = BATCH * SEQ;
constexpr int AW = 1024, RW = 1024, NIN = 5120, NH = 8, HD = 128;
constexpr int PH = 8, NK = 128, TOPK = 16, NE = 128;
constexpr float ALPHA = 1.18920711500272f, LN_EPS = 1e-5f;
constexpr int NPH = 11;
constexpr size_t MiB = 1u << 20;
constexpr size_t WS_CTL = 0, CTL_ZERO_BYTES = 128 * 1024;
constexpr int CW_BAR = 4096;
constexpr int CW_SEAM = 16384;
constexpr size_t WS_XCH = 1 * MiB;
constexpr size_t WS_ROPE = 2 * MiB;
constexpr size_t WS_WGT = 6 * MiB;
constexpr size_t WS_SU = 6 * MiB + 512 * 1024;
constexpr size_t WS_CHA = 7 * MiB, WS_CHH = 7 * MiB + 512 * 1024;
constexpr size_t WS_KEYB = 7 * MiB + 768 * 1024;
constexpr size_t WS_WOUT = 8 * MiB, WS_WQ = 16 * MiB, WS_WIN = 24 * MiB;
constexpr size_t WS_XB = 48 * MiB;
constexpr size_t WS_OP = 80 * MiB, WS_LSE = 128 * MiB;
constexpr size_t WS_H1B = 208 * MiB;
constexpr size_t WS_Q = 240 * MiB, WS_K = 256 * MiB, WS_V = 272 * MiB, WS_XR = 288 * MiB, WS_GGB = 304 * MiB;
constexpr size_t WS_Q2 = 240 * MiB;
constexpr size_t WS_IDX = 304 * MiB, WS_GATE = 308 * MiB;
constexpr size_t WS_UT8 = 320 * MiB, WS_VT8 = 352 * MiB;
constexpr size_t WS_REC1 = 384 * MiB, WS_PG = 416 * MiB;
constexpr size_t WS_H1Q = 384 * MiB;
constexpr size_t WS_MIX = 480 * MiB;
constexpr size_t WS_END = 512 * MiB;
constexpr int RING_OFF = 0, RING_BYTES = 131072;
constexpr int LDSCTL_OFF = RING_BYTES, MISC_OFF = LDSCTL_OFF + 320, PTRTAB_OFF = LDSCTL_OFF + 1024;
constexpr int LDS_BYTES = 147456;

#define GAS __attribute__((address_space(1)))
#define LAS __attribute__((address_space(3)))
typedef unsigned short bf16;
typedef unsigned v4u __attribute__((ext_vector_type(4)));
typedef unsigned v2u __attribute__((ext_vector_type(2)));
typedef float f32x4 __attribute__((ext_vector_type(4)));
typedef GAS unsigned gu32;
#define RLX_AGENT __ATOMIC_RELAXED, __HIP_MEMORY_SCOPE_AGENT
#define LDS_WAIT() asm volatile("s_waitcnt lgkmcnt(0)" ::: "memory")
#define VM_WAIT() asm volatile("s_waitcnt vmcnt(0)" ::: "memory")
__device__ __forceinline__ unsigned f2bf(float f) { return (unsigned)__builtin_bit_cast(unsigned short, (__bf16)f); }
__device__ __forceinline__ unsigned pk2(float lo, float hi) { typedef __bf16 bf2_ __attribute__((ext_vector_type(2))); typedef float f2_ __attribute__((ext_vector_type(2))); return __builtin_bit_cast(unsigned, __builtin_convertvector((f2_){lo, hi}, bf2_)); }
__device__ __forceinline__ float bf2f(unsigned short b) { return __builtin_bit_cast(float, ((unsigned)b) << 16); }
__device__ __forceinline__ float u2f(unsigned u) { return __builtin_bit_cast(float, u); }
__device__ __forceinline__ unsigned f2u(float f) { return __builtin_bit_cast(unsigned, f); }
__device__ __forceinline__ float bflo(unsigned w) { return __builtin_bit_cast(float, w << 16); }
__device__ __forceinline__ float bfhi(unsigned w) { return __builtin_bit_cast(float, w & 0xffff0000u); }
__device__ __forceinline__ float xor32(float x) {
    const v2u r = __builtin_bit_cast(v2u, __builtin_amdgcn_permlane32_swap(__builtin_bit_cast(unsigned, x), __builtin_bit_cast(unsigned, x), false, false));
    return __builtin_bit_cast(float, (threadIdx.x & 32) ? r.x : r.y);
}
__device__ __forceinline__ float xor16(float x) {
    const v2u r = __builtin_bit_cast(v2u, __builtin_amdgcn_permlane16_swap(__builtin_bit_cast(unsigned, x), __builtin_bit_cast(unsigned, x), false, false));
    return __builtin_bit_cast(float, (threadIdx.x & 16) ? r.x : r.y);
}
__device__ __forceinline__ float wave_sum(float v) {
    v += __builtin_bit_cast(float, __builtin_amdgcn_update_dpp(0, __builtin_bit_cast(int, v), 0xB1, 0xf, 0xf, true));
    v += __builtin_bit_cast(float, __builtin_amdgcn_update_dpp(0, __builtin_bit_cast(int, v), 0x4E, 0xf, 0xf, true));
    v += __shfl_xor(v, 4); v += __shfl_xor(v, 8);
    v += xor16(v); v += xor32(v);
    return v;
}
__device__ __forceinline__ float wave_max(float v) {
#pragma unroll
    for (int o = 1; o < 64; o <<= 1) v = fmaxf(v, __shfl_xor(v, o));
    return v;
}
__device__ __forceinline__ float gelu_tanh(float x) { const float u = 0.7978845608028654f * (x + 0.044715f * x * x * x); return x * __builtin_amdgcn_rcpf(1.0f + __expf(-2.0f * u)); }
__device__ __forceinline__ float sigmoidf_(float x) { return __builtin_amdgcn_rcpf(1.0f + __expf(-x)); }

#define XB_TMO      128
#define XB_XCNT(j)  (256  + 64 * (j))
#define XB_XSUB(j)  (1280 + 64 * (j))
#define XB_XGEN(j)  (2304 + 64 * (j))
#define XB_TOP      3328
#define XB_TOPGEN   3392
#define XCD_BAR_WORDS 3456
#define XB_SPIN_CAP (1u << 18)

__device__ __forceinline__ unsigned xb_ld(unsigned* p)              { return __hip_atomic_load(p, __ATOMIC_RELAXED, __HIP_MEMORY_SCOPE_AGENT); }
__device__ __forceinline__ unsigned xb_add(unsigned* p, unsigned v) { return __hip_atomic_fetch_add(p, v, __ATOMIC_RELAXED, __HIP_MEMORY_SCOPE_AGENT); }
__device__ __forceinline__ unsigned xb_xcc_id() { return (unsigned)__builtin_amdgcn_s_getreg((3 << 11) | 20) & 0xFu; }
#define XB_SPIN(cond, bar) do { unsigned _sp = 0; while (cond) { __builtin_amdgcn_s_sleep(1); \
    if ((++_sp & 255u) == 0u) { if (xb_ld(&(bar)[XB_TMO])) break; if (_sp > XB_SPIN_CAP) { atomicAdd(&(bar)[XB_TMO], 1u); break; } } } } while (0)

struct XcdBarrier {
    unsigned* bar; unsigned x;
    volatile LAS unsigned* st;
};

__device__ __forceinline__ XcdBarrier xcd_barrier_post(unsigned* bar, volatile LAS unsigned* st) {
    XcdBarrier b; b.bar = bar; b.x = xb_xcc_id(); b.st = st;
    if (threadIdx.x == 0) (void)xb_add(&bar[XB_XCNT(b.x)], 1u);
    return b;
}
__device__ __forceinline__ void xcd_barrier_complete(unsigned* bar, unsigned x, unsigned& nloc, unsigned& nx) {
    const unsigned G = gridDim.x * gridDim.y * gridDim.z;
    unsigned sum, cnt, mine, sp = 0u;
    for (;;) {
        sum = 0u; cnt = 0u; mine = 0u;
#pragma unroll
        for (unsigned j = 0; j < 16; ++j) { const unsigned c = xb_ld(&bar[XB_XCNT(j)]); sum += c; cnt += (c > 0u) ? 1u : 0u; mine = (j == x) ? c : mine; }
        if (sum == G) break;
        __builtin_amdgcn_s_sleep(1);
        if ((++sp & 255u) == 0u) { if (xb_ld(&bar[XB_TMO])) break; if (sp > XB_SPIN_CAP) { atomicAdd(&bar[XB_TMO], 1u); break; } }
    }
    nloc = mine > 0u ? mine : 1u; nx = cnt > 0u ? cnt : 1u;
}

__device__ __forceinline__ void xcd_barrier(const XcdBarrier& b) {
    asm volatile("s_waitcnt vmcnt(0)" ::: "memory");
    __syncthreads();
    if (threadIdx.x == 0) {
        unsigned* bar = b.bar;
        __builtin_amdgcn_s_waitcnt(0);
        unsigned nloc = b.st[0], nx = b.st[1];
        if (nloc == 0u) { xcd_barrier_complete(bar, b.x, nloc, nx); b.st[0] = nloc; b.st[1] = nx; }
        const unsigned old = xb_add(&bar[XB_XSUB(b.x)], 1u);
        const unsigned gen = old / nloc;
        if (old + 1u == (gen + 1u) * nloc) {
            __builtin_amdgcn_fence(__ATOMIC_RELEASE, "agent");
            asm volatile("s_waitcnt vmcnt(0)" ::: "memory");
            const unsigned og = xb_add(&bar[XB_TOP], 1u);
            const unsigned tg = og / nx;
            if (og + 1u == (tg + 1u) * nx) xb_add(&bar[XB_TOPGEN], 1u);
            else XB_SPIN(xb_ld(&bar[XB_TOPGEN]) == tg, bar);
            __builtin_amdgcn_fence(__ATOMIC_ACQUIRE, "agent");
            xb_add(&bar[XB_XGEN(b.x)], 1u);
            asm volatile("s_waitcnt vmcnt(0)" ::: "memory");
        } else {
            XB_SPIN(xb_ld(&bar[XB_XGEN(b.x)]) == gen, bar);
            __builtin_amdgcn_fence(__ATOMIC_ACQUIRE, "agent");
            asm volatile("s_waitcnt vmcnt(0)" ::: "memory");
        }
    }
    __syncthreads();
}


enum PtrIdx { PX = 0, PPOS, PW_IN, PCONV_W, PCONV_B, PW_A, PB_A, PW_X, PB_X, PLAM, PGN_ATTN, PGN_REC, PW_OUT, PLN1_G, PLN1_B, PWQ, PKEYS1, PKEYS2, PPU, PPV, PLN2_G, PLN2_B, POUT, PN };
struct Frame {
    LAS unsigned char* lds;
    volatile LAS unsigned* MISC;
    gu32* ctl;
    int tid, lane, wave;
    int vcu, G;
    unsigned char* ws;
    template <class Tp> __device__ __forceinline__ Tp* ptr(int k) const {
        volatile LAS unsigned* t = (volatile LAS unsigned*)(lds + PTRTAB_OFF) + 2 * k;
        const unsigned lo = (unsigned)__builtin_amdgcn_readfirstlane((int)t[0]), hi = (unsigned)__builtin_amdgcn_readfirstlane((int)t[1]);
        return (Tp*)(GAS Tp*)(((unsigned long long)hi << 32) | lo);
    }
};

template <bool ROPEPERM> __device__ __forceinline__ void p0_transpose_item(const float* W, int K, int N, bf16* WT, LAS float* scr, int item, int lane) {
    const int nblk = N / 32, kb = item / nblk, nb = item % nblk, k0 = 64 * kb, n0 = 32 * nb;
    {
        f32x4 t[8];
#pragma unroll
        for (int i = 0; i < 8; ++i) t[i] = __builtin_nontemporal_load((const f32x4*)(W + (size_t)(k0 + 8 * i + (lane >> 3)) * N + n0 + 4 * (lane & 7)));
#pragma unroll
        for (int i = 0; i < 8; ++i) { LAS float* d = scr + (8 * i + (lane >> 3)) * 33 + 4 * (lane & 7); d[0] = t[i].x; d[1] = t[i].y; d[2] = t[i].z; d[3] = t[i].w; }
    }
    LDS_WAIT(); asm volatile("" ::: "memory");
    const int c = lane & 7;
#pragma unroll
    for (int j = 0; j < 4; ++j) { const int n = (lane >> 3) + 8 * j; const LAS float* s = scr + (8 * c) * 33 + n;
        v4u o; o.x = pk2(s[0 * 33], s[1 * 33]); o.y = pk2(s[2 * 33], s[3 * 33]); o.z = pk2(s[4 * 33], s[5 * 33]); o.w = pk2(s[6 * 33], s[7 * 33]);
        int nr = n0 + n; if (ROPEPERM && nr < 2048) { const int d = nr & 127; nr = (nr & ~127) + 8 * ((d & 63) >> 2) + 4 * (d >> 6) + (d & 3); }
        *(v4u*)(WT + (size_t)nr * K + k0 + 8 * c) = o; }
    LDS_WAIT(); asm volatile("" ::: "memory");
}

__device__ __forceinline__ void p0_prep(Frame& F) {
    const float* const p_w_in = F.ptr<const float>(PW_IN);
    const float* const p_w_out = F.ptr<const float>(PW_OUT);
    const float* const p_wq = F.ptr<const float>(PWQ);
    const float* const p_x = F.ptr<const float>(PX);
    const float* const p_w_x = F.ptr<const float>(PW_X);
    const float* const p_w_a = F.ptr<const float>(PW_A);
    const int* const p_pos = F.ptr<const int>(PPOS);

    LAS float* scr = (LAS float*)(F.lds + RING_OFF + F.wave * 16384);
    const int gw = F.vcu * NWAVES + F.wave, NGW = F.G * NWAVES;
    constexpr int I_IN = (DM / 64) * (NIN / 32), I_O = (DM / 64) * (DM / 32), I_Q = I_O;
    bf16* Win_t = (bf16*)(F.ws + WS_WIN); bf16* Wout_t = (bf16*)(F.ws + WS_WOUT); bf16* Wq_t = (bf16*)(F.ws + WS_WQ);
    const int n_items = (F.G == 256) ? I_IN : I_IN + I_O + I_Q;
    for (int it = gw; it < n_items; it += NGW) {
        int r = it;
        if (r < I_IN) { p0_transpose_item<true>(p_w_in, DM, NIN, Win_t, scr, r, F.lane); continue; } r -= I_IN;
        if (r < I_O) { p0_transpose_item<false>(p_w_out, DM, DM, Wout_t, scr, r, F.lane); continue; } r -= I_O;
        p0_transpose_item<false>(p_wq, DM, DM, Wq_t, scr, r, F.lane);
    }
    const size_t gt = (size_t)blockIdx.x * NTHR + F.tid, GT = (size_t)F.G * NTHR;
    {
        const f32x4* x4 = (const f32x4*)p_x; v2u* xb = (v2u*)(F.ws + WS_XB);
        for (size_t i = gt; i < (size_t)T * DM / 4; i += GT) { const f32x4 v = __builtin_nontemporal_load(x4 + i); v2u o; o.x = pk2(v.x, v.y); o.y = pk2(v.z, v.w); xb[i] = o; }
    }
    {
        bf16* wgt = (bf16*)(F.ws + WS_WGT);
        for (size_t i = gt; i < (size_t)8 * 256 * 128; i += GT) { const int c = (int)(i & 127), col = (int)((i >> 7) & 255), n = (int)(i >> 15); const int g = col >> 7, dd = col & 127;
            wgt[i] = (bf16)f2bf((g ? p_w_x : p_w_a)[((size_t)n * 128 + c) * 128 + dd]); }
    }
    {
        const float* const p_k1 = F.ptr<const float>(PKEYS1); const float* const p_k2 = F.ptr<const float>(PKEYS2); bf16* kb = (bf16*)(F.ws + WS_KEYB);
        for (size_t i = gt; i < (size_t)2 * 128 * 128; i += GT) { const int tbl = (int)(i >> 14), e = (int)(i & 16383); const float v = (tbl ? p_k2 : p_k1)[e];
            const unsigned hi = f2bf(v); const float lo = v - bf2f((unsigned short)hi); kb[(size_t)tbl * 32768 + e] = (bf16)hi; kb[(size_t)tbl * 32768 + 16384 + e] = (bf16)f2bf(lo); }
    }
    {
        float* ct = (float*)(F.ws + WS_ROPE); float* st = ct + (size_t)T * 64;
        for (size_t i = gt; i < (size_t)T * 64; i += GT) {
            const int tok = (int)(i >> 6), k = (int)(i & 63);
            const float inv = expf(-(float)k * (9.210340371976184f / 64.0f));
            const float ang = (float)p_pos[tok] * inv;
            const double rev = (double)ang * 0.15915494309189535;
            const float fr = (float)(rev - floor(rev));
            ct[i] = __builtin_amdgcn_cosf(fr); st[i] = __builtin_amdgcn_sinf(fr);
        }
    }
}
__device__ __forceinline__ void p0_late_transposes(Frame& F, int wg, int nwg) {
    const float* const p_w_out = F.ptr<const float>(PW_OUT);
    const float* const p_wq = F.ptr<const float>(PWQ);
    LAS float* scr = (LAS float*)(F.lds + RING_OFF + F.wave * 16384);
    constexpr int I_O = (DM / 64) * (DM / 32);
    bf16* Wout_t = (bf16*)(F.ws + WS_WOUT); bf16* Wq_t = (bf16*)(F.ws + WS_WQ);
    __syncthreads();
    for (int it = wg * NWAVES + F.wave; it < 2 * I_O; it += nwg * NWAVES) {
        if (it < I_O) p0_transpose_item<false>(p_w_out, DM, DM, Wout_t, scr, it, F.lane); else p0_transpose_item<false>(p_wq, DM, DM, Wq_t, scr, it - I_O, F.lane);
    }
}

namespace att {
using bf16x8 = __attribute__((ext_vector_type(8))) short;
using s16x4 = __attribute__((ext_vector_type(4))) short;
using f32x16 = __attribute__((ext_vector_type(16))) float;
using u32x4 = __attribute__((ext_vector_type(4))) unsigned;
#define ATT_MFMA(a, b, c) __builtin_amdgcn_mfma_f32_32x32x16_bf16((a), (b), (c), 0, 0, 0)
__device__ __forceinline__ bf16x8 pack8(float a0, float a1, float a2, float a3, float a4, float a5, float a6, float a7) {
    u32x4 p;
    asm volatile("s_nop 1\n\tv_cvt_pk_bf16_f32 %0, %4, %5\n\tv_cvt_pk_bf16_f32 %1, %6, %7\n\tv_cvt_pk_bf16_f32 %2, %8, %9\n\tv_cvt_pk_bf16_f32 %3, %10, %11\n\ts_nop 1"
                 : "=&v"(p[0]), "=&v"(p[1]), "=&v"(p[2]), "=&v"(p[3]) : "v"(a0), "v"(a1), "v"(a2), "v"(a3), "v"(a4), "v"(a5), "v"(a6), "v"(a7));
    return __builtin_bit_cast(bf16x8, p);
}
template <int S> __device__ __forceinline__ void vt_read(unsigned base, s16x4 (&lo)[4], s16x4 (&hi)[4]) {
    asm volatile("ds_read_b64_tr_b16 %0, %8 offset:%9\n\tds_read_b64_tr_b16 %1, %8 offset:%10\n\tds_read_b64_tr_b16 %2, %8 offset:%11\n\tds_read_b64_tr_b16 %3, %8 offset:%12\n\t"
                 "ds_read_b64_tr_b16 %4, %8 offset:%13\n\tds_read_b64_tr_b16 %5, %8 offset:%14\n\tds_read_b64_tr_b16 %6, %8 offset:%15\n\tds_read_b64_tr_b16 %7, %8 offset:%16\n\ts_waitcnt lgkmcnt(0)"
                 : "=&v"(lo[0]), "=&v"(lo[1]), "=&v"(lo[2]), "=&v"(lo[3]), "=&v"(hi[0]), "=&v"(hi[1]), "=&v"(hi[2]), "=&v"(hi[3])
                 : "v"(base), "i"((2 * S) * 2048 + 0), "i"((2 * S) * 2048 + 512), "i"((2 * S) * 2048 + 1024), "i"((2 * S) * 2048 + 1536),
                   "i"((2 * S + 1) * 2048 + 0), "i"((2 * S + 1) * 2048 + 512), "i"((2 * S + 1) * 2048 + 1024), "i"((2 * S + 1) * 2048 + 1536) : "memory");
}
#define ATT_DMA(voff_, sbase_, lds_) asm volatile("s_mov_b32 m0, %2\n\ts_nop 0\n\tglobal_load_lds_dwordx4 %0, %1" :: "v"(voff_), "s"(sbase_), "s"(lds_) : "memory", "m0")
template <int PAT>
__device__ __forceinline__ void attn_round(const bf16* Q, const bf16* K, const bf16* V, bf16* OP, float* LSE, LAS unsigned char* lds, int b, int h, int g, int wave, int lane) {
    constexpr int d = (PAT == 0) ? 1 : (PAT == 1 ? 4 : 16);
    asm volatile("" : "+v"(lane));
    const int r = lane & 31, hh = lane >> 5;
    const int hf = wave >> 2, w4 = wave & 3;
    const int hi = 2 * g + hf, hio = 2 * g + (hf ^ 1);
    const int c = (PAT == 0) ? 0 : (PAT == 1 ? (hi >> 2) : hi);
    const int j0 = (PAT == 0) ? 4 * hi : (PAT == 1 ? 4 * (hi & 3) : 0), j0o = (PAT == 0) ? 4 * hio : (PAT == 1 ? 4 * (hio & 3) : 0);
    const int tlo = (j0 >= 4) ? j0 - 4 : 0, nt = j0 + 4 - tlo;
    const int nto = (j0o >= 4) ? 8 : 4;
    const int nsteps = (nt > nto) ? nt : nto;
    const int j = j0 + w4, kt0 = (j >= 4) ? j - 4 : 0;
    const size_t tokq = (size_t)b * SEQ + (size_t)(32 * j + r) * d + c;
    bf16x8 qf[8];
    { const bf16x8* qp = (const bf16x8*)(Q + tokq * AW + h * HD + 8 * hh);
#pragma unroll
      for (int s = 0; s < 8; ++s) qf[s] = qp[2 * s]; }
    f32x16 o[4];
#pragma unroll
    for (int dt = 0; dt < 4; ++dt)
#pragma unroll
        for (int i = 0; i < 16; ++i) o[dt][i] = 0.f;
    float m = -1.0e30f, l = 0.f;
    const unsigned hbase = (unsigned)__builtin_amdgcn_readfirstlane((int)(unsigned)(size_t)lds) + (unsigned)hf * 65536u;
    const unsigned troff = (unsigned)((4 * hh + ((lane & 15) >> 2)) * 64 + (16 * ((lane >> 4) & 1) + 4 * (lane & 3)) * 2);
    const unsigned kfoff = 8192u + (unsigned)r * 256u;
    const char* const Kb = (const char*)(K + ((size_t)b * SEQ + c) * AW + h * HD);
    const char* const Vb = (const char*)(V + ((size_t)b * SEQ + c) * AW + h * HD);
    constexpr unsigned rowb = (unsigned)(d * AW * 2);
    unsigned ko[2], vo[2];
#pragma unroll
    for (int q = 0; q < 2; ++q) { const int i = 2 * w4 + q; const int row = 4 * i + (lane >> 4); ko[q] = (unsigned)row * rowb + (unsigned)(((lane & 15) ^ (row & 15)) * 16);
        const int key = 8 * (i >> 1) + ((lane & 31) >> 2); vo[q] = (unsigned)key * rowb + (unsigned)((4 * (2 * (i & 1) + (lane >> 5)) + (lane & 3)) * 16); }
#define ATT_ISSUE(t_) do { const size_t tb_ = (size_t)(tlo + (t_)) * 32 * rowb; const unsigned sl_ = hbase + (unsigned)((t_) & 3) * 16384u + (unsigned)(2 * w4) * 1024u; \
        ATT_DMA(ko[0], Kb + tb_, sl_ + 8192u); ATT_DMA(ko[1], Kb + tb_, sl_ + 8192u + 1024u); ATT_DMA(vo[0], Vb + tb_, sl_); ATT_DMA(vo[1], Vb + tb_, sl_ + 1024u); } while (0)
    asm volatile("s_waitcnt lgkmcnt(0)\n\ts_barrier" ::: "memory");
    ATT_ISSUE(0); ATT_ISSUE(1); ATT_ISSUE(2);
#pragma unroll
    for (int s = 0; s < 8; ++s) asm volatile("" :: "v"(qf[s]));
#define ATT_QK(dst_, t_) do { const unsigned sb_ = hbase + (unsigned)((t_) & 3) * 16384u; bf16x8 kf[8]; \
        _Pragma("unroll") for (int t = 0; t < 8; ++t) kf[t] = *(const LAS bf16x8*)(size_t)(sb_ + kfoff + (unsigned)(((2 * t + hh) ^ (r & 15)) * 16)); \
        __builtin_amdgcn_sched_barrier(0); \
        _Pragma("unroll") for (int i = 0; i < 16; ++i) dst_[i] = 0.f; \
        _Pragma("unroll") for (int t = 0; t < 8; ++t) dst_ = ATT_MFMA(kf[t], qf[t], dst_); } while (0)
#define ATT_ACTIVE(s_) ((s_) < nt && tlo + (s_) >= kt0 && tlo + (s_) <= j)
    asm volatile("s_waitcnt vmcnt(8)" ::: "memory");
    asm volatile("s_waitcnt lgkmcnt(0)\n\ts_barrier" ::: "memory");
    f32x16 sacc;
#pragma unroll
    for (int i = 0; i < 16; ++i) sacc[i] = 0.f;
    if (ATT_ACTIVE(0)) ATT_QK(sacc, 0);
#pragma unroll 1
    for (int s = 0; s < nsteps; ++s) {
        {   const int last = (s + 2 < nt - 1) ? s + 2 : nt - 1; const int ahead = last - (s + 1);
            if (ahead >= 1) asm volatile("s_waitcnt vmcnt(4)" ::: "memory"); else asm volatile("s_waitcnt vmcnt(0)" ::: "memory"); }
        asm volatile("s_waitcnt lgkmcnt(0)\n\ts_barrier" ::: "memory");
        if (s + 3 < nt) ATT_ISSUE(s + 3);
        f32x16 snext;
#pragma unroll
        for (int i = 0; i < 16; ++i) snext[i] = 0.f;
        if (ATT_ACTIVE(s + 1)) ATT_QK(snext, s + 1);
        const int kt = tlo + s;
        if (ATT_ACTIVE(s)) {
            const unsigned sb = hbase + (unsigned)(s & 3) * 16384u;
            if (kt == j) {
#pragma unroll
                for (int i = 0; i < 16; ++i) { const int kr = (i & 3) + 8 * (i >> 2) + 4 * hh; sacc[i] = (kr <= r) ? sacc[i] : -1.0e30f; }
            }
            if (kt == j - 4) {
#pragma unroll
                for (int i = 0; i < 16; ++i) { const int kr = (i & 3) + 8 * (i >> 2) + 4 * hh; sacc[i] = (kr >= r) ? sacc[i] : -1.0e30f; }
            }
            float mx = sacc[0];
#pragma unroll
            for (int i = 1; i < 16; ++i) mx = fmaxf(mx, sacc[i]);
            mx = fmaxf(mx, xor32(mx));
            const float mn = fmaxf(m, mx);
            const float alpha = __builtin_amdgcn_exp2f(m - mn);
            float ps = 0.f;
#pragma unroll
            for (int i = 0; i < 16; ++i) { sacc[i] = __builtin_amdgcn_exp2f(sacc[i] - mn); ps += sacc[i]; }
            ps += xor32(ps);
            l = l * alpha + ps; m = mn;
#pragma unroll
            for (int dt = 0; dt < 4; ++dt)
#pragma unroll
                for (int i = 0; i < 16; ++i) o[dt][i] *= alpha;
            const unsigned trb = sb + troff;
            {
                const bf16x8 pb = pack8(sacc[0], sacc[1], sacc[2], sacc[3], sacc[4], sacc[5], sacc[6], sacc[7]);
                s16x4 lo[4], hi4[4]; vt_read<0>(trb, lo, hi4);
#pragma unroll
                for (int dt = 0; dt < 4; ++dt) { const bf16x8 va = __builtin_shufflevector(lo[dt], hi4[dt], 0, 1, 2, 3, 4, 5, 6, 7); o[dt] = ATT_MFMA(va, pb, o[dt]); }
            }
            {
                const bf16x8 pb = pack8(sacc[8], sacc[9], sacc[10], sacc[11], sacc[12], sacc[13], sacc[14], sacc[15]);
                s16x4 lo[4], hi4[4]; vt_read<1>(trb, lo, hi4);
#pragma unroll
                for (int dt = 0; dt < 4; ++dt) { const bf16x8 va = __builtin_shufflevector(lo[dt], hi4[dt], 0, 1, 2, 3, 4, 5, 6, 7); o[dt] = ATT_MFMA(va, pb, o[dt]); }
            }
        }
        sacc = snext;
    }
#undef ATT_QK
#undef ATT_ACTIVE
    const float inv = __builtin_amdgcn_rcpf(l);
    bf16* op = OP + (size_t)PAT * T * AW + tokq * AW + h * HD + 8 * hh;
#pragma unroll
    for (int dt = 0; dt < 4; ++dt)
#pragma unroll
        for (int gq = 0; gq < 4; gq += 2) {
            v2u wa, wb_; wa.x = pk2(o[dt][4 * gq] * inv, o[dt][4 * gq + 1] * inv); wa.y = pk2(o[dt][4 * gq + 2] * inv, o[dt][4 * gq + 3] * inv);
            wb_.x = pk2(o[dt][4 * gq + 4] * inv, o[dt][4 * gq + 5] * inv); wb_.y = pk2(o[dt][4 * gq + 6] * inv, o[dt][4 * gq + 7] * inv);
            const v2u sx = __builtin_bit_cast(v2u, __builtin_amdgcn_permlane32_swap(wa.x, wb_.x, false, false)), sy = __builtin_bit_cast(v2u, __builtin_amdgcn_permlane32_swap(wa.y, wb_.y, false, false));
            v4u w4; w4.x = sx.x; w4.y = sy.x; w4.z = sx.y; w4.w = sy.y;
            *(v4u*)(op + 32 * dt + 8 * gq) = w4; }
    if (hh == 0) LSE[(size_t)PAT * T * NH + tokq * NH + h] = m + __builtin_amdgcn_logf(l);
#undef ATT_ISSUE
}
}

__device__ __forceinline__ void p3_attn_mfma(Frame& F) {
    const bf16* Q = (const bf16*)(F.ws + WS_Q); const bf16* K = (const bf16*)(F.ws + WS_K); const bf16* V = (const bf16*)(F.ws + WS_V);
    bf16* OP = (bf16*)(F.ws + WS_OP); float* LSE = (float*)(F.ws + WS_LSE);
    for (int w = F.vcu; w < 256; w += F.G) {
        const int bh = w >> 3, g = w & 7, b = bh >> 3, h = bh & 7;
        att::attn_round<0>(Q, K, V, OP, LSE, F.lds, b, h, g, F.wave, F.lane);
        att::attn_round<1>(Q, K, V, OP, LSE, F.lds, b, h, g, F.wave, F.lane);
        att::attn_round<2>(Q, K, V, OP, LSE, F.lds, b, h, g, F.wave, F.lane);
    }
    asm volatile("s_waitcnt lgkmcnt(0)\n\ts_barrier" ::: "memory");
}


namespace rec {
using bf16x8 = __attribute__((ext_vector_type(8))) short;
using f32x16 = __attribute__((ext_vector_type(16))) float;
constexpr int AROW = 272;
__device__ __forceinline__ void rec_wave_item(Frame& F, int b, int chunk, int n, int wq, LAS unsigned char* hb) {
    const float* const p_conv_b = F.ptr<const float>(PCONV_B);
    const float* const p_conv_w = F.ptr<const float>(PCONV_W);
    const float* const p_b_x = F.ptr<const float>(PB_X);
    const float* const p_b_a = F.ptr<const float>(PB_A);
    const float* const p_lam = F.ptr<const float>(PLAM);
    const bf16* XR = (const bf16*)(F.ws + WS_XR); const bf16* GGB = (const bf16*)(F.ws + WS_GGB);
    const bf16* WGT = (const bf16*)(F.ws + WS_WGT);
    bf16* REC1 = (bf16*)(F.ws + WS_REC1); bf16* PG = (bf16*)(F.ws + WS_PG);
    float* CHA = (float*)(F.ws + WS_CHA); float* CHH = (float*)(F.ws + WS_CHH);
    const int lane = F.lane, r = lane & 31, hh = lane >> 5;
    const size_t tok0 = (size_t)b * SEQ + (size_t)chunk * 128;
    LAS unsigned char* const ggt = hb + 17408 + wq * 6144;
    LAS unsigned char* const r1t = ggt + 2048;
    LAS unsigned char* const pgt = ggt + 4096;
    const int pc = lane & 15, rq = lane >> 4; const int cb = n * 128 + 8 * pc;
    f32x4 cw0[4], cw1[4];
#pragma unroll
    for (int j = 0; j < 4; ++j) { cw0[j] = *(const f32x4*)(p_conv_w + j * RW + cb); cw1[j] = *(const f32x4*)(p_conv_w + j * RW + cb + 4); }
    const f32x4 cbi0 = *(const f32x4*)(p_conv_b + cb), cbi1 = *(const f32x4*)(p_conv_b + cb + 4);
    bf16x8 bfa[8], bfx[8];
    { const bf16x8* wa = (const bf16x8*)(WGT + ((size_t)n * 256 + 32 * wq + r) * 128 + 8 * hh); const bf16x8* wx = (const bf16x8*)(WGT + ((size_t)n * 256 + 128 + 32 * wq + r) * 128 + 8 * hh);
#pragma unroll
      for (int s = 0; s < 8; ++s) { bfa[s] = wa[2 * s]; bfx[s] = wx[2 * s]; } }
    const int chl = 32 * wq + r, ch = n * 128 + chl;
    const float bias_a = p_b_a[ch], bias_x = p_b_x[ch];
    const float sp8 = -8.0f * log1pf(expf(-p_lam[ch]));
    float h = 0.f, P = 1.f;
    v4u xw[2][4], gq[2];
#define REC_ISSUE(rt_) do { _Pragma("unroll") for (int i = 0; i < 2; ++i) { const int t_ = 32 * (rt_) + 8 * wq + rq + 4 * i; \
            _Pragma("unroll") for (int j = 0; j < 4; ++j) { const int tt_ = t_ - (3 - j); const size_t tk_ = (chunk * 128 + tt_ >= 0) ? tok0 + tt_ : tok0;     \
                xw[i][j] = *(const v4u*)(XR + tk_ * RW + cb); } } \
        _Pragma("unroll") for (int k = 0; k < 2; ++k) { const int idx = lane + 64 * k, row = idx >> 2, p4 = idx & 3; gq[k] = *(const v4u*)(GGB + (tok0 + 32 * (rt_) + row) * RW + n * 128 + 32 * wq + 8 * p4); } } while (0)
    REC_ISSUE(0);
#pragma unroll 1
    for (int rt = 0; rt < 4; ++rt) {
        LAS unsigned char* const img = hb + (rt & 1) * 8704;
#pragma unroll
        for (int i = 0; i < 2; ++i) { const int row = 8 * wq + rq + 4 * i, t = 32 * rt + row, s = chunk * 128 + t;
            f32x4 a0 = cbi0, a1 = cbi1;
#pragma unroll
            for (int j = 0; j < 4; ++j) { const int ds = 3 - j; const bool ok = (s - ds >= 0);
                v4u w_ = xw[i][j]; w_.x = ok ? w_.x : 0u; w_.y = ok ? w_.y : 0u; w_.z = ok ? w_.z : 0u; w_.w = ok ? w_.w : 0u;
                a0.x += cw0[j].x * bflo(w_.x); a0.y += cw0[j].y * bfhi(w_.x); a0.z += cw0[j].z * bflo(w_.y); a0.w += cw0[j].w * bfhi(w_.y);
                a1.x += cw1[j].x * bflo(w_.z); a1.y += cw1[j].y * bfhi(w_.z); a1.z += cw1[j].z * bflo(w_.w); a1.w += cw1[j].w * bfhi(w_.w); }
            v4u o; o.x = pk2(a0.x, a0.y); o.y = pk2(a0.z, a0.w); o.z = pk2(a1.x, a1.y); o.w = pk2(a1.z, a1.w);
            *(LAS v4u*)(img + row * AROW + pc * 16) = o; }
#pragma unroll
        for (int k = 0; k < 2; ++k) { const int idx = lane + 64 * k, row = idx >> 2, p4 = idx & 3; *(LAS v4u*)(ggt + row * 64 + p4 * 16) = gq[k]; }
        __builtin_amdgcn_sched_barrier(0);
        { const int rtn = (rt < 3) ? rt + 1 : 3; REC_ISSUE(rtn); }
        __builtin_amdgcn_sched_barrier(0);
        asm volatile("s_waitcnt lgkmcnt(0)\n\ts_barrier" ::: "memory");
        f32x16 acca, accx;
#pragma unroll
        for (int i = 0; i < 16; ++i) { acca[i] = 0.f; accx[i] = 0.f; }
#pragma unroll
        for (int s = 0; s < 8; ++s) { const bf16x8 af = *(const LAS bf16x8*)(img + r * AROW + (16 * s + 8 * hh) * 2);
            acca = __builtin_amdgcn_mfma_f32_32x32x16_bf16(af, bfa[s], acca, 0, 0, 0); accx = __builtin_amdgcn_mfma_f32_32x32x16_bf16(af, bfx[s], accx, 0, 0, 0); }
        float av[16], bv[16];
#pragma unroll
        for (int i = 0; i < 16; ++i) {
            const int tl = (i & 3) + 8 * (i >> 2) + 4 * hh;
            const float rg = sigmoidf_(acca[i] + bias_a), ig = sigmoidf_(accx[i] + bias_x);
            const float xcv = bf2f(*(const LAS unsigned short*)(img + tl * AROW + chl * 2));
            const float a = __expf(rg * sp8);
            const float t1 = fmaxf(1.0f - a * a, 1.0e-30f); av[i] = a; bv[i] = (t1 * __builtin_amdgcn_rsqf(t1)) * (ig * xcv);
        }
        float Ar[4], Br[4], hin[4], pin[4];
#pragma unroll
        for (int q = 0; q < 4; ++q) { float A = av[4 * q], B = bv[4 * q];
#pragma unroll
            for (int e = 1; e < 4; ++e) { B = B * av[4 * q + e] + bv[4 * q + e]; A = A * av[4 * q + e]; }
            Ar[q] = A; Br[q] = B; }
#pragma unroll
        for (int k = 0; k < 8; ++k) { const int q = k >> 1; const bool own = (hh == (k & 1));
            if (own) { hin[q] = h; pin[q] = P; }
            const float ho = Ar[q] * h + Br[q], po = P * Ar[q];
            const float hx = xor32(ho), px = xor32(po);
            h = own ? ho : hx; P = own ? po : px; }
#pragma unroll
        for (int q = 0; q < 4; ++q) { float hl = hin[q], pl_ = pin[q];
#pragma unroll
            for (int e = 0; e < 4; ++e) { hl = av[4 * q + e] * hl + bv[4 * q + e]; pl_ = pl_ * av[4 * q + e];
                const int tl = 4 * (2 * q + hh) + e; const float g = bf2f(*(const LAS unsigned short*)(ggt + tl * 64 + r * 2));
                *(LAS unsigned short*)(r1t + tl * 64 + r * 2) = (unsigned short)f2bf(hl * g); *(LAS unsigned short*)(pgt + tl * 64 + r * 2) = (unsigned short)f2bf(pl_ * g); } }
        LDS_WAIT(); asm volatile("" ::: "memory");
#pragma unroll
        for (int k = 0; k < 2; ++k) { const int idx = lane + 64 * k, row = idx >> 2, p4 = idx & 3; const size_t o = (tok0 + 32 * rt + row) * RW + n * 128 + 32 * wq + 8 * p4;
            *(v4u*)(REC1 + o) = *(const LAS v4u*)(r1t + row * 64 + p4 * 16); *(v4u*)(PG + o) = *(const LAS v4u*)(pgt + row * 64 + p4 * 16); }
        LDS_WAIT(); asm volatile("" ::: "memory");
    }
#undef REC_ISSUE
    if (hh == 1) { CHA[((size_t)b * 16 + chunk) * RW + ch] = P; CHH[((size_t)b * 16 + chunk) * RW + ch] = h; }
}
}

__device__ __forceinline__ void p9_convert_tables_q(Frame& F, int row_lo, int row_hi, int wg, int nwg);
__device__ __forceinline__ void p3_rec_local(Frame& F) {
    LAS unsigned char* hb = F.lds + (F.wave >> 2) * 49152;
    const int NW = F.G * NWAVES;
    for (int id = F.vcu * NWAVES + F.wave; id < BATCH * 16 * 8 * 4; id += NW) {
        asm volatile("s_waitcnt lgkmcnt(0)\n\ts_barrier" ::: "memory");
        rec::rec_wave_item(F, id >> 9, (id >> 5) & 15, (id >> 2) & 7, id & 3, hb); }
    asm volatile("s_waitcnt lgkmcnt(0)\n\ts_barrier" ::: "memory");
}

__device__ __forceinline__ void p5_mix(Frame& F) {
    const float* const p_gn_rec = F.ptr<const float>(PGN_REC);
    const float* const p_gn_attn = F.ptr<const float>(PGN_ATTN);

    const bf16* OP = (const bf16*)(F.ws + WS_OP); const float* LSE = (const float*)(F.ws + WS_LSE); const bf16* REC1 = (const bf16*)(F.ws + WS_REC1); const bf16* PG = (const bf16*)(F.ws + WS_PG); bf16* MIX = (bf16*)(F.ws + WS_MIX);
    const float* CHA = (const float*)(F.ws + WS_CHA); const float* CHH = (const float*)(F.ws + WS_CHH);
    const int lane = F.lane;
    LAS float* carry = (LAS float*)F.lds;
    for (int tile = blockIdx.x; tile < T / 32; tile += F.G) {
      { const int b = tile >> 6, chunk = (tile >> 2) & 15;
        for (int ch = F.tid; ch < RW; ch += NTHR) { float c = 0.f; for (int m = 0; m < chunk; ++m) c = CHA[((size_t)b * 16 + m) * RW + ch] * c + CHH[((size_t)b * 16 + m) * RW + ch]; carry[ch] = c; } }
      __syncthreads();
      for (int tk = 0; tk < 4; ++tk) { const int tok = tile * 32 + F.wave * 4 + tk;
#pragma unroll
        for (int half = 0; half < 2; ++half) {
            f32x4 v[4]; float ss = 0.f;
            if (half == 0) {
#pragma unroll
                for (int j = 0; j < 4; ++j) {
                    const int hd = 2 * j + (lane >> 5);
                    const float l0 = LSE[(size_t)tok * NH + hd], l1 = LSE[(size_t)T * NH + (size_t)tok * NH + hd], l2 = LSE[(size_t)2 * T * NH + (size_t)tok * NH + hd];
                    const float mx = fmaxf(l0, fmaxf(l1, l2));
                    float w0 = __builtin_amdgcn_exp2f(l0 - mx), w1 = __builtin_amdgcn_exp2f(l1 - mx), w2 = __builtin_amdgcn_exp2f(l2 - mx);
                    const float wi = __builtin_amdgcn_rcpf(w0 + w1 + w2); w0 *= wi; w1 *= wi; w2 *= wi;
                    const size_t off = (size_t)tok * AW + 4 * lane + 256 * j;
                    const v2u a = __builtin_nontemporal_load((const v2u*)(OP + off)), bb = __builtin_nontemporal_load((const v2u*)(OP + (size_t)T * AW + off)), cc = __builtin_nontemporal_load((const v2u*)(OP + (size_t)2 * T * AW + off));
                    v[j].x = w0 * bflo(a.x) + w1 * bflo(bb.x) + w2 * bflo(cc.x); v[j].y = w0 * bfhi(a.x) + w1 * bfhi(bb.x) + w2 * bfhi(cc.x);
                    v[j].z = w0 * bflo(a.y) + w1 * bflo(bb.y) + w2 * bflo(cc.y); v[j].w = w0 * bfhi(a.y) + w1 * bfhi(bb.y) + w2 * bfhi(cc.y);
                }
            } else {
#pragma unroll
                for (int j = 0; j < 4; ++j) { const size_t off = (size_t)tok * RW + 4 * lane + 256 * j; const v2u a = __builtin_nontemporal_load((const v2u*)(REC1 + off)), pg = __builtin_nontemporal_load((const v2u*)(PG + off));
                    const f32x4 cy = *(const LAS f32x4*)(carry + 4 * lane + 256 * j);
                    v[j].x = bflo(a.x) + bflo(pg.x) * cy.x; v[j].y = bfhi(a.x) + bfhi(pg.x) * cy.y; v[j].z = bflo(a.y) + bflo(pg.y) * cy.z; v[j].w = bfhi(a.y) + bfhi(pg.y) * cy.w; }
            }
#pragma unroll
            for (int j = 0; j < 4; ++j) ss += (v[j].x * v[j].x + v[j].y * v[j].y) + (v[j].z * v[j].z + v[j].w * v[j].w);
            const f32x4* g4 = (const f32x4*)(half ? p_gn_rec : p_gn_attn) + lane;
            const float rs = __builtin_amdgcn_rsqf(wave_sum(ss) * (1.0f / 1024.0f) + LN_EPS);
            v2u* o = (v2u*)(MIX + (size_t)tok * DM + half * 1024) + lane;
#pragma unroll
            for (int j = 0; j < 4; ++j) { const f32x4 g = g4[64 * j]; v2u w; w.x = pk2(v[j].x * rs * g.x, v[j].y * rs * g.y); w.y = pk2(v[j].z * rs * g.z, v[j].w * rs * g.w); o[64 * j] = w; }
        }
      }
      __syncthreads();
    }
}

namespace tk {
using f32x16 = __attribute__((ext_vector_type(16))) float;
#define TK_CE(a, b) { const float hi_ = __builtin_fmaxf(a, b), lo_ = __builtin_fminf(a, b); a = hi_; b = lo_; }
__device__ __forceinline__ void insert16(float (&l)[16], float x) {
#pragma unroll
    for (int s = 0; s < 16; ++s) { const float hi = __builtin_fmaxf(l[s], x); x = __builtin_fminf(l[s], x); l[s] = hi; }
}
__device__ __forceinline__ void bmerge16(float (&v)[16]) {
#pragma unroll
    for (int j = 8; j >= 1; j >>= 1)
#pragma unroll
        for (int i = 0; i < 16; ++i) { const int l = i ^ j; if (l > i) TK_CE(v[i], v[l]); }
}
__device__ __forceinline__ void bsort16(float (&v)[16]) {
#pragma unroll
    for (int k = 2; k <= 16; k <<= 1)
#pragma unroll
        for (int j = k >> 1; j >= 1; j >>= 1)
#pragma unroll
            for (int i = 0; i < 16; ++i) { const int l = i ^ j; if (l > i) { if ((i & k) == 0 || k == 16) { TK_CE(v[i], v[l]); } else { TK_CE(v[l], v[i]); } } }
}
__device__ __forceinline__ float packlow(float v, unsigned idx, unsigned mask) { return u2f((f2u(v) & ~mask) | idx); }
__device__ __forceinline__ void topk_item(Frame& F, int tile, int h) {
    const float* const p_keys2 = F.ptr<const float>(PKEYS2);
    const float* const p_keys1 = F.ptr<const float>(PKEYS1);

    const bf16* Q2 = (const bf16*)(F.ws + WS_Q2); const float* SU = (const float*)(F.ws + WS_SU);
    const bf16* KB = (const bf16*)(F.ws + WS_KEYB);
    typedef __attribute__((ext_vector_type(8))) short bf16x8_;
    const int lane = F.lane, x = lane & 31, kk = lane >> 5;
    const int tok = tile * 32 + x;
    float lst[2][16];
#pragma unroll
    for (int half = 0; half < 2; ++half) {
        if (half) __syncthreads();
#pragma unroll
        for (int i = 0; i < 8; ++i) { const int L = F.tid + 512 * i, row = L >> 4, pc = L & 15;
            *(LAS v4u*)(F.lds + 65536 + row * 256 + ((pc ^ (row & 15)) << 4)) = *(const v4u*)(KB + (size_t)half * 32768 + (size_t)row * 128 + pc * 8); }
        __syncthreads();
        bf16x8_ qf[8];
        { const bf16x8_* qp = (const bf16x8_*)(Q2 + (size_t)tok * DM + h * 256 + half * 128 + 8 * kk);
#pragma unroll
          for (int s = 0; s < 8; ++s) qf[s] = qp[2 * s]; }
        float l16[16];
#pragma unroll
        for (int rt = 0; rt < 4; ++rt) {
            f32x16 acc;
#pragma unroll
            for (int i = 0; i < 16; ++i) acc[i] = 0.f;
            const LAS unsigned char* krow = F.lds + 65536 + (32 * rt + x) * 256; const int rsw = (32 * rt + x) & 15;
            bf16x8_ ah[8], al[8];
#pragma unroll
            for (int s = 0; s < 8; ++s) { const int po = ((2 * s + kk) ^ rsw) << 4; ah[s] = *(const LAS bf16x8_*)(krow + po); al[s] = *(const LAS bf16x8_*)(krow + 32768 + po); }
#pragma unroll
            for (int s = 0; s < 8; ++s) { acc = __builtin_amdgcn_mfma_f32_32x32x16_bf16(al[s], qf[s], acc, 0, 0, 0); }
#pragma unroll
            for (int s = 0; s < 8; ++s) { acc = __builtin_amdgcn_mfma_f32_32x32x16_bf16(ah[s], qf[s], acc, 0, 0, 0); }
            float nw[16];
#pragma unroll
            for (int i = 0; i < 16; ++i) { const unsigned key = (unsigned)(32 * rt + (i & 3) + 8 * (i >> 2) + 4 * kk); nw[i] = packlow(acc[i], key, 127u); }
            bsort16(nw);
            if (rt == 0) {
#pragma unroll
                for (int s = 0; s < 16; ++s) l16[s] = nw[s];
            } else {
#pragma unroll
                for (int s = 0; s < 16; ++s) l16[s] = __builtin_fmaxf(l16[s], nw[15 - s]);
                bmerge16(l16);
            }
        }
        float mg[16];
#pragma unroll
        for (int s = 0; s < 16; ++s) mg[s] = __builtin_fmaxf(l16[s], xor32(l16[15 - s]));
        bmerge16(mg);
#pragma unroll
        for (int s = 0; s < 16; ++s) lst[half][s] = mg[s];
    }
    float c16[16];
#pragma unroll
    for (int s = 0; s < 16; ++s) c16[s] = -3.0e38f;
    {
        int cnt = 0;
#pragma unroll
        for (int a = 0; a < 16; ++a)
#pragma unroll
            for (int bb = 0; bb < 16; ++bb) if ((a + 1) * (bb + 1) <= 16) {
                if ((cnt & 1) == 0) {
                    int a2 = a, b2 = bb + 1; if ((a2 + 1) * (b2 + 1) > 16) { a2 = a + 1; b2 = 0; }
                    const bool has2 = (a2 < 16);
                    const float v0 = packlow(lst[0][a] + lst[1][bb], (unsigned)((a << 4) | bb), 255u);
                    const float v1 = has2 ? packlow(lst[0][a2 & 15] + lst[1][b2 & 15], (unsigned)(((a2 & 15) << 4) | (b2 & 15)), 255u) : -3.0e38f;
                    insert16(c16, kk ? v1 : v0);
                }
                ++cnt;
            }
    }
    float win[16];
#pragma unroll
    for (int s = 0; s < 16; ++s) win[s] = __builtin_fmaxf(c16[s], xor32(c16[15 - s]));
    float mx = win[0];
#pragma unroll
    for (int s = 1; s < 16; ++s) mx = __builtin_fmaxf(mx, win[s]);
    float e[16], es = 0.f;
#pragma unroll
    for (int s = 0; s < 16; ++s) { e[s] = __expf(win[s] - mx); es += e[s]; }
    const float inv = 1.0f / es;
    if (kk == 0) {
#pragma unroll
        for (int s = 0; s < 16; ++s) {
            const unsigned ab = f2u(win[s]) & 255u, a = ab >> 4, bb = ab & 15u;
            unsigned i1 = 0, i2 = 0;
#pragma unroll
            for (int q = 0; q < 16; ++q) { i1 = (a == (unsigned)q) ? (f2u(lst[0][q]) & 127u) : i1; i2 = (bb == (unsigned)q) ? (f2u(lst[1][q]) & 127u) : i2; }
            const unsigned id = i1 * NK + i2;
            v4u en; en.x = id << 7; en.y = f2u(e[s] * inv * SU[16384 + id]); en.z = f2u(SU[id]); en.w = f2u(SU[32768 + id]);
            *(LAS v4u*)(F.lds + (x >> 2) * 8192 + ((x & 3) * 128 + h * 16 + s) * 16) = en;
            asm volatile("" ::: "memory");
        }
    }
}
}
__device__ __forceinline__ void p9_topk_mfma(Frame& F) {
    for (int tile = blockIdx.x; tile < T / 32; tile += F.G) tk::topk_item(F, tile, F.wave);
}

typedef unsigned v4u_ __attribute__((ext_vector_type(4)));
using bf16x2_t = __attribute__((ext_vector_type(2))) __bf16;
__device__ __forceinline__ float dot2bf(unsigned a, unsigned b, float c) { return __builtin_amdgcn_fdot2_f32_bf16(__builtin_bit_cast(bf16x2_t, a), __builtin_bit_cast(bf16x2_t, b), c, false); }
constexpr int NPASS = 32, SLICE_BYTES = 16384 * 128;


constexpr int CONV_SPLIT = 32768, CONV_R1 = 22528;
constexpr int NPASSU = 8;
constexpr int NPASSQ = 16, SLICEQ_BYTES = 16384 * 128;
__device__ __forceinline__ void p9_quant_row(Frame& F, int r, const f32x4 (&v)[8]) {
    const int lane = F.lane; const int tbl = r >> 14, e = r & 16383;
    if (tbl == 0) {
        float ss = 0.f;
#pragma unroll
        for (int j = 0; j < 8; ++j) ss += (v[j].x * v[j].x + v[j].y * v[j].y) + (v[j].z * v[j].z + v[j].w * v[j].w);
        ss = wave_sum(ss);
        const float step = fmaxf(0.335f * sqrtf(ss * (1.0f / 2048.0f)), 1e-30f), qs = 1.0f / step;
        unsigned char* dst4 = F.ws + WS_UT8 + (size_t)e * 128 + (size_t)(lane >> 1) * 4;
        int sni = 0;
#pragma unroll
        for (int j = 0; j < 8; ++j) {
            const float MG = 12582912.0f;
            const unsigned z0 = f2u(__builtin_fminf(__builtin_fmaxf(fmaf(v[j].x, qs, 7.5f), 0.f), 15.f) + MG), z1 = f2u(__builtin_fminf(__builtin_fmaxf(fmaf(v[j].y, qs, 7.5f), 0.f), 15.f) + MG);
            const unsigned z2 = f2u(__builtin_fminf(__builtin_fmaxf(fmaf(v[j].z, qs, 7.5f), 0.f), 15.f) + MG), z3 = f2u(__builtin_fminf(__builtin_fmaxf(fmaf(v[j].w, qs, 7.5f), 0.f), 15.f) + MG);
            const unsigned pa = (z1 << 4) | z0, pb = (z3 << 4) | z2;
            const unsigned mine = (((pb << 8) | pa) & 0xffffu) ^ 0x8888u;
            sni = __builtin_amdgcn_sdot8((int)mine, 0x1111, sni, false);
            const unsigned other = (unsigned)__builtin_amdgcn_update_dpp(0, (int)mine, 0xB1, 0xf, 0xf, true);
            if ((lane & 1) == 0) *(unsigned*)(dst4 + (size_t)j * SLICEQ_BYTES) = mine | (other << 16); }
        const float sn = wave_sum((float)sni);
        if (lane == 0) { ((float*)(F.ws + WS_SU))[e] = step; ((float*)(F.ws + WS_SU))[32768 + e] = sn; }
    } else {
        float ss = 0.f;
#pragma unroll
        for (int j = 0; j < 8; ++j) ss += (v[j].x * v[j].x + v[j].y * v[j].y) + (v[j].z * v[j].z + v[j].w * v[j].w);
        ss = wave_sum(ss);
        const float sc = fmaxf(0.5f * sqrtf(ss * (1.0f / 2048.0f)), 1e-30f), qs = 1.0f / sc;
        unsigned char* dst4 = F.ws + WS_VT8 + (size_t)e * 128 + (size_t)(lane >> 1) * 4;
#pragma unroll
        for (int j = 0; j < 8; ++j) {
            unsigned r = 0u;
            r = __builtin_amdgcn_cvt_scalef32_pk_fp4_f32(r, v[j].x * qs, v[j].y * qs, 1.0f, 0);
            r = __builtin_amdgcn_cvt_scalef32_pk_fp4_f32(r, v[j].z * qs, v[j].w * qs, 1.0f, 1);
            const unsigned mine = r & 0xffffu;
            const unsigned other = (unsigned)__builtin_amdgcn_update_dpp(0, (int)mine, 0xB1, 0xf, 0xf, true);
            if ((lane & 1) == 0) *(unsigned*)(dst4 + (size_t)j * SLICEQ_BYTES) = mine | (other << 16); }
        if (lane == 0) ((float*)(F.ws + WS_SU))[16384 + e] = sc;
    }
}
__device__ __forceinline__ void p9_convert_tables_q(Frame& F, int row_lo, int row_hi, int wg, int nwg) {
    const float* const p_pv = F.ptr<const float>(PPV);
    const float* const p_pu = F.ptr<const float>(PPU);
    const int gw = wg * NWAVES + F.wave, NGW = nwg * NWAVES, lane = F.lane;
    if (row_lo + gw >= row_hi) return;
    const int rlast = row_hi - 1;
#define P9_SRC(r_) ((const f32x4*)((((r_) >> 14) ? p_pv : p_pu) + (size_t)((r_) & 16383) * DM) + lane)
    f32x4 va[8], vb[8];
    { const int r0 = row_lo + gw, r1 = min(r0 + NGW, rlast); const f32x4* s0 = P9_SRC(r0); const f32x4* s1 = P9_SRC(r1);
#pragma unroll
      for (int j = 0; j < 8; ++j) va[j] = __builtin_nontemporal_load(s0 + 64 * j);
#pragma unroll
      for (int j = 0; j < 8; ++j) vb[j] = __builtin_nontemporal_load(s1 + 64 * j); }
    for (int r = row_lo + gw; r < row_hi; r += 2 * NGW) {
        const int r1 = r + NGW, n0 = min(r + 2 * NGW, rlast), n1 = min(r + 3 * NGW, rlast);
        f32x4 na[8], nb[8];
        { const f32x4* s0 = P9_SRC(n0); const f32x4* s1 = P9_SRC(n1);
#pragma unroll
          for (int j = 0; j < 8; ++j) na[j] = __builtin_nontemporal_load(s0 + 64 * j);
#pragma unroll
          for (int j = 0; j < 8; ++j) nb[j] = __builtin_nontemporal_load(s1 + 64 * j); }
        __builtin_amdgcn_sched_barrier(0);
        p9_quant_row(F, r, va);
        if (r1 < row_hi) p9_quant_row(F, r1, vb);
        __builtin_amdgcn_sched_barrier(0);
#pragma unroll
        for (int j = 0; j < 8; ++j) { va[j] = na[j]; vb[j] = nb[j]; }
    }
#undef P9_SRC
}

typedef float f32x2_ __attribute__((ext_vector_type(2)));
__device__ __forceinline__ void p10_peer_q(Frame& F) {
    const float* const p_ln2_g = F.ptr<const float>(PLN2_G);
    const float* const p_ln2_b = F.ptr<const float>(PLN2_B);
    float* const p_out = F.ptr<float>(POUT);

    const int lane = F.lane, slot = lane >> 3, piece = lane & 7;
    LAS v4u* ent = (LAS v4u*)(F.lds + F.wave * 8192);
    const int pc16 = piece * 16;
    const __amdgpu_buffer_rsrc_t rsWS = __builtin_amdgcn_make_buffer_rsrc((void*)F.ws, (short)0, (int)WS_END, 0x00020000);
    const __amdgpu_buffer_rsrc_t rsG = __builtin_amdgcn_make_buffer_rsrc((void*)p_ln2_g, (short)0, DM * 4, 0x00020000);
    const __amdgpu_buffer_rsrc_t rsB = __builtin_amdgcn_make_buffer_rsrc((void*)p_ln2_b, (short)0, DM * 4, 0x00020000);
    const __amdgpu_buffer_rsrc_t rsO = __builtin_amdgcn_make_buffer_rsrc((void*)p_out, (short)0, T * DM * 4, 0x00020000);
    for (int tile = blockIdx.x; tile < T / 32; tile += F.G) {
        const int tw0 = tile * 32 + F.wave * 4;
        LDS_WAIT(); asm volatile("" ::: "memory");
        const LAS unsigned* idl = (const LAS unsigned*)(ent + slot);
        const LAS v4u* enl = (const LAS v4u*)(ent + slot);
        const LAS v2u* en2 = (const LAS v2u*)(ent + slot);
#define UQ_ISSUE(buf, bb, so_) do { unsigned vo_[8]; asm volatile("" ::: "memory"); _Pragma("unroll") for (int q = 0; q < 8; ++q) vo_[q] = idl[32 * ((bb) * 8 + q)]; asm volatile("" ::: "memory"); \
            _Pragma("unroll") for (int q = 0; q < 8; ++q) buf[q] = __builtin_bit_cast(v4u, __builtin_amdgcn_raw_buffer_load_b128(rsWS, (int)(vo_[q] + pc16), (int)WS_UT8 + (so_), 0)); } while (0)
#define VQ_ISSUE(buf, cbuf, bb, so_) do { v2u en_[8]; asm volatile("" ::: "memory"); _Pragma("unroll") for (int q = 0; q < 8; ++q) en_[q] = cen2[8 * ((bb) * 8 + q)]; asm volatile("" ::: "memory"); \
            _Pragma("unroll") for (int q = 0; q < 8; ++q) { cbuf[q] = u2f(en_[q].y); buf[q] = __builtin_bit_cast(v4u, __builtin_amdgcn_raw_buffer_load_b128(rsWS, (int)(en_[q].x + pc16), (int)WS_VT8 + (so_), 0)); } } while (0)
        {
            int acc[64];
#pragma unroll
            for (int i = 0; i < 64; ++i) acc[i] = 0;
            LAS unsigned char* xl = F.lds + 65536 + F.wave * 8192;
            int sumx[4] = {0, 0, 0, 0};
#pragma unroll
            for (int k = 0; k < 8; ++k) { const v4u t = __builtin_bit_cast(v4u, __builtin_amdgcn_raw_buffer_load_b128(rsWS, lane * 16, (int)WS_H1Q + (tw0 + (k >> 1)) * DM + (k & 1) * 1024, 0));
                int sx = sumx[k >> 1];
                sx = __builtin_amdgcn_sdot4((int)t.x, 0x01010101, sx, false); sx = __builtin_amdgcn_sdot4((int)t.y, 0x01010101, sx, false); sx = __builtin_amdgcn_sdot4((int)t.z, 0x01010101, sx, false); sx = __builtin_amdgcn_sdot4((int)t.w, 0x01010101, sx, false);
                sumx[k >> 1] = sx;
#define NIB4(X_) ({ unsigned c_ = (X_); c_ = (c_ | (c_ >> 4)) & 0x00ff00ffu; (c_ | (c_ >> 8)) & 0xffffu; })
#define HI4(X_) NIB4(((X_) >> 4) & 0x0f0f0f0fu)
#define LO4(X_) NIB4(((X_) & 0x0f0f0f0fu) ^ 0x08080808u)
                v2u h_, l_; h_.x = HI4(t.x) | (HI4(t.y) << 16); h_.y = HI4(t.z) | (HI4(t.w) << 16); l_.x = LO4(t.x) | (LO4(t.y) << 16); l_.y = LO4(t.z) | (LO4(t.w) << 16);
#undef NIB4
#undef HI4
#undef LO4
                *(LAS v2u*)(xl + (k >> 1) * 2048 + (k & 1) * 512 + lane * 8) = h_; *(LAS v2u*)(xl + (k >> 1) * 2048 + 1024 + (k & 1) * 512 + lane * 8) = l_; }
            LDS_WAIT(); asm volatile("" ::: "memory");
            v4u wb[2][8]; v4u xa, xb;
            UQ_ISSUE(wb[0], 0, 0);
#pragma unroll 1
            for (int p = 0; p < NPASSU; ++p) {
                const int soff = p * SLICEQ_BYTES; const int pn = (p + 1 < NPASSU) ? p + 1 : p;
#pragma unroll
                for (int b = 0; b < 8; ++b) {
                    if (b < 7) UQ_ISSUE(wb[(b + 1) & 1], b + 1, soff); else UQ_ISSUE(wb[0], 0, pn * SLICEQ_BYTES);
                    if ((b & 1) == 0) { const LAS unsigned char* xp = xl + (b >> 1) * 2048 + 128 * p + 16 * piece; xa = *(const LAS v4u*)xp; xb = *(const LAS v4u*)(xp + 1024); }
                    __builtin_amdgcn_sched_barrier(0);
#pragma unroll
                    for (int q = 0; q < 8; ++q) { const int i = b * 8 + q; const v4u w = wb[b & 1][q];
                        int a = acc[i];
#define U8(WW, XH, XL) { const int t_ = __builtin_amdgcn_sdot8((int)(WW), (int)(XH), 0, false); a = (t_ << 4) + a; a = __builtin_amdgcn_sdot8((int)(WW), (int)(XL), a, false); }
                        U8(w.x, xa.x, xb.x) U8(w.y, xa.y, xb.y) U8(w.z, xa.z, xb.z) U8(w.w, xa.w, xb.w)
#undef U8
                        acc[i] = a; }
                    __builtin_amdgcn_sched_barrier(0);
                }
            }
            asm volatile("" ::: "memory");
            const int p0 = lane & 1, p1 = (lane >> 1) & 1, p2 = (lane >> 2) & 1;
            float sxc[4];
#pragma unroll
            for (int tk = 0; tk < 4; ++tk) { int s = sumx[tk]; s += __shfl_xor(s, 1); s += __shfl_xor(s, 2); s += __shfl_xor(s, 4); s += __shfl_xor(s, 8); s += __shfl_xor(s, 16); s += __shfl_xor(s, 32); sxc[tk] = 0.5f * (float)s; }
            const float sxl = p0 ? (p1 ? sxc[3] : sxc[2]) : (p1 ? sxc[1] : sxc[0]);
            int r16[16], r8[8];
            {   int r32[32];
#pragma unroll
                for (int k = 0; k < 32; ++k) { const int keep = p0 ? acc[32 + k] : acc[k], send = p0 ? acc[k] : acc[32 + k]; r32[k] = keep + __builtin_amdgcn_update_dpp(0, send, 0xB1, 0xf, 0xf, true); }
#pragma unroll
                for (int k = 0; k < 16; ++k) { const int keep = p1 ? r32[16 + k] : r32[k], send = p1 ? r32[k] : r32[16 + k]; r16[k] = keep + __builtin_amdgcn_update_dpp(0, send, 0x4E, 0xf, 0xf, true); } }
#pragma unroll
            for (int k = 0; k < 8; ++k) { const int keep = p2 ? r16[8 + k] : r16[k], send = p2 ? r16[k] : r16[8 + k]; r8[k] = keep + __shfl_xor(send, 4); }
            const int ibase = 32 * p0 + 16 * p1 + 8 * p2;
#pragma unroll
            for (int k = 0; k < 8; ++k) { const int i = ibase + k;
                const float gte = u2f(idl[32 * i + 1]), sue = u2f(idl[32 * i + 2]), sne = u2f(idl[32 * i + 3]); const float z = ((float)r8[k] + 8.0f * sne + sxl) * sue * (8.0f / 127.0f);
                ((LAS unsigned*)(ent + slot))[32 * i + 1] = f2u(gte * gelu_tanh(z)); }
            LDS_WAIT(); asm volatile("" ::: "memory");
        }
        LAS v2u* const cent = (LAS v2u*)(F.lds + 65536 + F.wave * 8192);
        {   v2u t_[8];
#pragma unroll
            for (int k = 0; k < 8; ++k) { const v4u e_ = ent[lane + 64 * k]; t_[k].x = e_.x; t_[k].y = e_.y; }
#pragma unroll
            for (int k = 0; k < 8; ++k) cent[lane + 64 * k] = t_[k]; }
        LDS_WAIT(); asm volatile("" ::: "memory");
        const LAS v2u* const cen2 = cent + slot;
        LAS unsigned char* const rA = F.lds + F.wave * 8192;
        LAS unsigned char* const rB = F.lds + 65536 + F.wave * 8192 + 4096;
        v2u r6[4], r7[4];
#pragma unroll
        for (int tk = 0; tk < 4; ++tk) { r6[tk].x = 0u; r6[tk].y = 0u; r7[tk].x = 0u; r7[tk].y = 0u; }
        const int b3 = (lane >> 3) & 1, b4 = (lane >> 4) & 1, b5 = (lane >> 5) & 1;
        const int dsl = 32 * piece + 16 * b5 + 8 * b4 + 4 * b3;
        float rs[4], rq[4];
#pragma unroll
        for (int tk = 0; tk < 4; ++tk) { rs[tk] = 0.f; rq[tk] = 0.f; }
        v2u hres[4]; v4u wb[2][8]; float cb[2][8];
#pragma unroll
        for (int tk = 0; tk < 4; ++tk) hres[tk] = __builtin_bit_cast(v2u, __builtin_amdgcn_raw_buffer_load_b64(rsWS, dsl * 2, (int)WS_H1B + ((tw0 + tk) * DM) * 2, 0));
        VQ_ISSUE(wb[0], cb[0], 0, 0);
#pragma unroll 1
        for (int p = 0; p < NPASSU; ++p) {
            const int soff = p * SLICEQ_BYTES; const int pn = (p + 1 < NPASSU) ? p + 1 : p;
            v2u hresn[4]; f32x2_ o2[16];
#pragma unroll
            for (int b = 0; b < 8; ++b) {
                if (b < 7) VQ_ISSUE(wb[(b + 1) & 1], cb[(b + 1) & 1], b + 1, soff); else VQ_ISSUE(wb[0], cb[0], 0, pn * SLICEQ_BYTES);
                if (b == 5) {
#pragma unroll
                    for (int tk = 0; tk < 4; ++tk) hresn[tk] = __builtin_bit_cast(v2u, __builtin_amdgcn_raw_buffer_load_b64(rsWS, dsl * 2, (int)WS_H1B + ((tw0 + tk) * DM + 256 * pn) * 2, 0));
                }
                __builtin_amdgcn_sched_barrier(0);
#pragma unroll
                for (int q = 0; q < 8; ++q) { v4u w = wb[b & 1][q]; const float c = cb[b & 1][q]; const f32x2_ cc = (f32x2_){c, c};
#define VQ_ACC(K, WW) { const f32x2_ t0_ = __builtin_amdgcn_cvt_scalef32_pk_f32_fp4((WW), 1.0f, 0), t1_ = __builtin_amdgcn_cvt_scalef32_pk_f32_fp4((WW), 1.0f, 1), t2_ = __builtin_amdgcn_cvt_scalef32_pk_f32_fp4((WW), 1.0f, 2), t3_ = __builtin_amdgcn_cvt_scalef32_pk_f32_fp4((WW), 1.0f, 3); \
                        if (((b & 1) == 0) && q == 0) { o2[4 * K] = cc * t0_; o2[4 * K + 1] = cc * t1_; o2[4 * K + 2] = cc * t2_; o2[4 * K + 3] = cc * t3_; }     \
                        else { o2[4 * K] = __builtin_elementwise_fma(cc, t0_, o2[4 * K]); o2[4 * K + 1] = __builtin_elementwise_fma(cc, t1_, o2[4 * K + 1]); o2[4 * K + 2] = __builtin_elementwise_fma(cc, t2_, o2[4 * K + 2]); o2[4 * K + 3] = __builtin_elementwise_fma(cc, t3_, o2[4 * K + 3]); } }
                    VQ_ACC(0, w.x) VQ_ACC(1, w.y) VQ_ACC(2, w.z) VQ_ACC(3, w.w)
#undef VQ_ACC
                    asm volatile("" : "+v"(o2[0]), "+v"(o2[1]), "+v"(o2[2]), "+v"(o2[3]), "+v"(o2[4]), "+v"(o2[5]), "+v"(o2[6]), "+v"(o2[7]), "+v"(o2[8]), "+v"(o2[9]), "+v"(o2[10]), "+v"(o2[11]), "+v"(o2[12]), "+v"(o2[13]), "+v"(o2[14]), "+v"(o2[15]));
                }
                if (b & 1) {
                    const int tk = b >> 1;
                    float s1[16], s2[8], t4[4];
#pragma unroll
                    for (int k = 0; k < 16; ++k) { const float lo_ = (k & 1) ? o2[k >> 1].y : o2[k >> 1].x, hi_ = (k & 1) ? o2[8 + (k >> 1)].y : o2[8 + (k >> 1)].x;
                        const v2u sw = __builtin_bit_cast(v2u, __builtin_amdgcn_permlane32_swap(f2u(lo_), f2u(hi_), false, false)); s1[k] = u2f(sw.x) + u2f(sw.y); }
#pragma unroll
                    for (int k = 0; k < 8; ++k) { const v2u sw = __builtin_bit_cast(v2u, __builtin_amdgcn_permlane16_swap(f2u(s1[k]), f2u(s1[8 + k]), false, false)); s2[k] = u2f(sw.x) + u2f(sw.y); }
#pragma unroll
                    for (int k = 0; k < 4; ++k) { const float keep = b3 ? s2[4 + k] : s2[k], send = b3 ? s2[k] : s2[4 + k]; t4[k] = keep + __shfl_xor(send, 8); }
                    const float r0 = ALPHA * bflo(hres[tk].x) + t4[0], r1 = ALPHA * bfhi(hres[tk].x) + t4[1], r2 = ALPHA * bflo(hres[tk].y) + t4[2], r3 = ALPHA * bfhi(hres[tk].y) + t4[3];
                    rs[tk] += (r0 + r1) + (r2 + r3); rq[tk] += (r0 * r0 + r1 * r1) + (r2 * r2 + r3 * r3);
                    v2u pk; pk.x = pk2(r0, r1); pk.y = pk2(r2, r3);
                    if (p < 4) *(LAS v2u*)(rA + (p * 4 + tk) * 512 + lane * 8) = pk;
                    else if (p < 6) *(LAS v2u*)(rB + ((p - 4) * 4 + tk) * 512 + lane * 8) = pk;
                    else { r6[tk].x = (p == 6) ? pk.x : r6[tk].x; r6[tk].y = (p == 6) ? pk.y : r6[tk].y; r7[tk].x = (p == 7) ? pk.x : r7[tk].x; r7[tk].y = (p == 7) ? pk.y : r7[tk].y; }
                }
                __builtin_amdgcn_sched_barrier(0);
            }
#pragma unroll
            for (int tk = 0; tk < 4; ++tk) hres[tk] = hresn[tk];
        }
#undef UQ_ISSUE
#undef VQ_ISSUE
        float mean[4], rstd[4];
#pragma unroll
        for (int tk = 0; tk < 4; ++tk) { const float s = wave_sum(rs[tk]), q = wave_sum(rq[tk]); mean[tk] = s * (1.0f / DM); rstd[tk] = 1.0f / sqrtf(fmaxf(q * (1.0f / DM) - mean[tk] * mean[tk], 0.f) + LN_EPS); }
        LDS_WAIT(); asm volatile("" ::: "memory");
#pragma unroll
        for (int p = 0; p < NPASSU; ++p) {
            const v4u gw_ = __builtin_bit_cast(v4u, __builtin_amdgcn_raw_buffer_load_b128(rsG, dsl * 4, p * 1024, 0)), bw_ = __builtin_bit_cast(v4u, __builtin_amdgcn_raw_buffer_load_b128(rsB, dsl * 4, p * 1024, 0));
#pragma unroll
            for (int tk = 0; tk < 4; ++tk) {
                v2u pk;
                if (p < 4) pk = *(const LAS v2u*)(rA + (p * 4 + tk) * 512 + lane * 8); else if (p < 6) pk = *(const LAS v2u*)(rB + ((p - 4) * 4 + tk) * 512 + lane * 8); else pk = (p == 6) ? r6[tk] : r7[tk];
                const float vx = bflo(pk.x), vy = bfhi(pk.x), vz = bflo(pk.y), vw = bfhi(pk.y);
                v4u st; st.x = f2u((vx - mean[tk]) * rstd[tk] * u2f(gw_.x) + u2f(bw_.x)); st.y = f2u((vy - mean[tk]) * rstd[tk] * u2f(gw_.y) + u2f(bw_.y));
                st.z = f2u((vz - mean[tk]) * rstd[tk] * u2f(gw_.z) + u2f(bw_.z)); st.w = f2u((vw - mean[tk]) * rstd[tk] * u2f(gw_.w) + u2f(bw_.w));
                __builtin_amdgcn_raw_buffer_store_b128(st, rsO, dsl * 4, ((tw0 + tk) * DM + 256 * p) * 4, 2); }
        }
        LDS_WAIT(); asm volatile("" ::: "memory");
    }
}

struct OrderSlice : pg8::StaticOrder { int i0, n;
    __device__ __forceinline__ bool next(int i, pg8::Unit& u) const { return (i < n) && pg8::StaticOrder::next(i0 + i, u); } };

struct Args { const void* in[22]; float* out; unsigned char* ws; int ph_lo, ph_hi; };
__global__ void __launch_bounds__(NWAVES * 64, 2) fwd(Args args) {
    extern __shared__ __attribute__((aligned(16))) unsigned char lds[];
    Frame F;
    F.lds = (LAS unsigned char*)lds;
    F.MISC = (volatile LAS unsigned*)(F.lds + MISC_OFF);
    F.tid = threadIdx.x; F.lane = F.tid & 63; F.wave = __builtin_amdgcn_readfirstlane(F.tid >> 6);
    F.G = gridDim.x; { const int bx = blockIdx.x; F.vcu = (F.G % 8 == 0) ? (bx % 8) * (F.G / 8) + bx / 8 : bx; }
    unsigned char* ws = args.ws; F.ws = ws;
    F.ctl = (gu32*)(ws + WS_CTL);
    for (int u = F.tid; u < (LDS_BYTES - LDSCTL_OFF) / 4; u += NWAVES * 64) ((LAS unsigned*)(F.lds + LDSCTL_OFF))[u] = 0u;
    __syncthreads();
    if (F.tid == 0) { volatile LAS unsigned long long* t = (volatile LAS unsigned long long*)(F.lds + PTRTAB_OFF);
#pragma unroll
        for (int k = 0; k < 22; ++k) t[k] = (unsigned long long)args.in[k];
        t[POUT] = (unsigned long long)args.out; }
    __syncthreads();
    XcdBarrier bar; bar.bar = (unsigned*)(F.ctl + CW_BAR); bar.x = 0; bar.st = nullptr;
    if (MK_ONE_LAUNCH) bar = xcd_barrier_post((unsigned*)(F.ctl + CW_BAR), F.MISC + 8);
    const int lo = args.ph_lo, hi = args.ph_hi;
#define IN(k) (lo <= (k) && (k) < hi)
#define SEAM(k) do { if (MK_ONE_LAUNCH && IN(k) && IN((k) + 1)) xcd_barrier(bar); } while (0)
    if (IN(0)) { p0_prep(F); SEAM(0); }
    if (IN(1)) {
        pg8::Gemm g{(const pg8::bf16_t*)(ws + WS_XB), (const pg8::bf16_t*)(ws + WS_WIN), T, NIN, DM}; pg8::StaticOrder S; S.init(T, NIN, F.G, (int)blockIdx.x);
        pg8::EpiProj E{(pg8::bf16_t*)(ws + WS_Q), (size_t)T * 1024, (const float*)(ws + WS_ROPE), (const float*)(ws + WS_ROPE) + (size_t)T * 64, 0.08838834764831845f * 1.4426950408889634f};
        if (F.G == 256 && blockIdx.x >= 128) {
            OrderSlice S0; S0.init(T, NIN, F.G, (int)blockIdx.x); S0.i0 = 0; S0.n = 1;
            pg8::gemm_phase<pg8::EpiProj, OrderSlice, true, true>(F.lds + RING_OFF, g, S0, E);
            p0_late_transposes(F, (int)blockIdx.x - 128, 128); p9_convert_tables_q(F, 0, CONV_R1, (int)blockIdx.x - 128, 128);
            __syncthreads();
            OrderSlice S1; S1.init(T, NIN, F.G, (int)blockIdx.x); S1.i0 = 1; S1.n = 1;
            pg8::gemm_phase<pg8::EpiProj, OrderSlice, true, true>(F.lds + RING_OFF, g, S1, E);
        } else {
            pg8::gemm_phase<pg8::EpiProj, pg8::StaticOrder, true, true>(F.lds + RING_OFF, g, S, E);
            if (F.G == 256) p9_convert_tables_q(F, CONV_R1, CONV_SPLIT, (int)blockIdx.x, 128);
        }
        SEAM(1);
    }
    if (IN(3)) { p3_attn_mfma(F); p3_rec_local(F); { const bool split = (F.G == 256); p9_convert_tables_q(F, split ? CONV_SPLIT : 0, 2 * 16384, (int)blockIdx.x, F.G); } SEAM(3); }
    if (IN(5)) { p5_mix(F); SEAM(5); }
    if (IN(6)) {
        pg8::Gemm g{(const pg8::bf16_t*)(ws + WS_MIX), (const pg8::bf16_t*)(ws + WS_WOUT), T, DM, DM}; pg8::StaticOrder S; S.init(T, DM, F.G, (int)blockIdx.x);
        pg8::EpiResLn E{ws, PTRTAB_OFF, PX, PLN1_G, PLN1_B, WS_H1B, WS_H1Q, WS_XCH, WS_CTL + (size_t)CW_SEAM * 4, WS_XB, ALPHA, LN_EPS};
        pg8::gemm_phase<pg8::EpiResLn, pg8::StaticOrder, false, true>(F.lds + RING_OFF, g, S, E);
        SEAM(6);
    }
    if (IN(8)) {
        pg8::Gemm g{(const pg8::bf16_t*)(ws + WS_H1B), (const pg8::bf16_t*)(ws + WS_WQ), T, DM, DM}; pg8::StaticOrder S; S.init(T, DM, F.G, (int)blockIdx.x);
        pg8::EpiBf16Plain E{(pg8::bf16_t*)(ws + WS_Q2), DM};
        pg8::gemm_phase<pg8::EpiBf16Plain, pg8::StaticOrder, true, true>(F.lds + RING_OFF, g, S, E);
        SEAM(8);
    }
    if (IN(9)) { p9_topk_mfma(F); LDS_WAIT(); __syncthreads(); }
    if (IN(10)) { p10_peer_q(F); }
#undef IN
#undef SEAM
}

extern "C" void kernel_launch(void* const* d_in, const int* in_sizes, int n_in, void* d_out, int out_size, void* d_ws, size_t ws_size, hipStream_t stream) {
    static int grid = 0;
    if (grid == 0) {
        if (n_in != 22 || out_size != T * DM || ws_size < WS_END) { fprintf(stderr, "kernel_launch: unexpected shapes: n_in %d out %d ws %zu\n", n_in, out_size, ws_size); grid = -1; return; }
        int dev = 0, cus = 0, per_cu = 0;
        if (hipGetDevice(&dev) != hipSuccess || hipDeviceGetAttribute(&cus, hipDeviceAttributeMultiprocessorCount, dev) != hipSuccess) { grid = -1; return; }
        if (hipFuncSetAttribute((const void*)fwd, hipFuncAttributeMaxDynamicSharedMemorySize, LDS_BYTES) != hipSuccess) { fprintf(stderr, "kernel_launch: hipFuncSetAttribute failed\n"); grid = -1; return; }
        if (hipOccupancyMaxActiveBlocksPerMultiprocessor(&per_cu, (const void*)fwd, NWAVES * 64, LDS_BYTES) != hipSuccess || per_cu < 1) fprintf(stderr, "kernel_launch: occupancy query reports %d\n", per_cu);
        (void)hipGetLastError();
        grid = cus;
    }
    if (grid < 0) return;
    if (hipMemsetAsync((char*)d_ws + WS_CTL, 0, CTL_ZERO_BYTES, stream) != hipSuccess) return;
    Args a{};
    for (int i = 0; i < 22; ++i) a.in[i] = d_in[i];
    a.out = (float*)d_out; a.ws = (unsigned char*)d_ws;
#if MK_ONE_LAUNCH
    a.ph_lo = 0; a.ph_hi = NPH;
    hipLaunchKernelGGL(fwd, dim3(grid), dim3(NWAVES * 64), LDS_BYTES, stream, a);
#else
    for (int p = 0; p < NPH; ++p) { a.ph_lo = p; a.ph_hi = p + 1; hipLaunchKernelGGL(fwd, dim3(grid), dim3(NWAVES * 64), LDS_BYTES, stream, a); }
#endif
}
```
